# Optimizing an MI355X kernel written in HIP

```python
import math
import jax, jax.numpy as jnp
from jax import lax
import numpy as np

D_MODEL = 1024
BATCH = 4
SEQ = 8192
DEPTH = 1
DEC_BATCH = 32
DEC_SEQ = 2048
PAST_LEN = 128

N_FGROUPS = 4
FGROUP_DIM = 64
F_WIDTH = N_FGROUPS * FGROUP_DIM
N_HEADS = 6
QK_NOPE_DIM = 128
QK_ROPE_DIM = 64
V_HEAD_DIM = 128
QK_HEAD_DIM = QK_NOPE_DIM + QK_ROPE_DIM
Q_LORA_RANK = 384
KV_LORA_RANK = 256
ATTN_WIDTH = N_HEADS * V_HEAD_DIM
MIX_WIDTH = F_WIDTH + ATTN_WIDTH
IN_WIDTH = F_WIDTH + Q_LORA_RANK + KV_LORA_RANK + QK_ROPE_DIM
D_FF = ((8 * D_MODEL // 3 + 255) // 256) * 256
ROPE_THETA = 10000.0
EPS = 1e-6
Q_BLOCK = 128
SM_SCALE = 1.0 / math.sqrt(QK_HEAD_DIM)

kernel_name = "fnet_mla_parallel_encoder"


def rms_norm(x, g):
    xf = x.astype(jnp.float32)
    y = xf * lax.rsqrt(jnp.mean(xf * xf, axis=-1, keepdims=True) + EPS)
    return (y * g.astype(jnp.float32)).astype(x.dtype)


def rope_tables(seq_len):
    inv_freq = 1.0 / (ROPE_THETA ** (jnp.arange(0, QK_ROPE_DIM, 2, dtype=jnp.float32) / QK_ROPE_DIM))
    ang = jnp.arange(seq_len, dtype=jnp.float32)[:, None] * inv_freq[None, :]
    return jnp.cos(ang), jnp.sin(ang)


def apply_rope(x, cos, sin):
    xf = x.astype(jnp.float32)
    x1, x2 = jnp.split(xf, 2, axis=-1)
    return jnp.concatenate([x1 * cos - x2 * sin, x2 * cos + x1 * sin], axis=-1).astype(x.dtype)


def fourier_mix(u):
    b, s, _ = u.shape
    ug = u.reshape(b, s, N_FGROUPS, FGROUP_DIM).astype(jnp.float32)
    f = jnp.fft.fft2(ug, axes=(1, 3), norm="ortho").real
    return f.reshape(b, s, F_WIDTH).astype(u.dtype)


def latent_attention(q_nope, q_rope, k_nope, k_rope, v):
    b, s, h, _ = q_nope.shape
    nb = s // Q_BLOCK
    qn = q_nope.reshape(b, nb, Q_BLOCK, h, QK_NOPE_DIM).swapaxes(0, 1)
    qr = q_rope.reshape(b, nb, Q_BLOCK, h, QK_ROPE_DIM).swapaxes(0, 1)

    def block(args):
        qn_b, qr_b = args
        sc = (jnp.einsum('bqhd,bkhd->bhqk', qn_b, k_nope, preferred_element_type=jnp.float32)
              + jnp.einsum('bqhr,bkr->bhqk', qr_b, k_rope, preferred_element_type=jnp.float32)) * SM_SCALE
        p = jax.nn.softmax(sc, axis=-1)
        return jnp.einsum('bhqk,bkhd->bqhd', p.astype(v.dtype), v)

    o = lax.map(block, (qn, qr))
    return o.swapaxes(0, 1).reshape(b, s, h * V_HEAD_DIM)


def token_mixer(xn, w_in, q_norm_g, w_q_up, kv_norm_g, w_kv_up, w_out):
    b, s, _ = xn.shape
    hcat = xn @ w_in
    o1 = F_WIDTH
    o2 = o1 + Q_LORA_RANK
    o3 = o2 + KV_LORA_RANK
    u_f = hcat[..., :o1]
    c_q = hcat[..., o1:o2]
    c_kv = hcat[..., o2:o3]
    k_rope_raw = hcat[..., o3:]
    y_f = fourier_mix(u_f)
    cos, sin = rope_tables(s)
    q = (rms_norm(c_q, q_norm_g) @ w_q_up).reshape(b, s, N_HEADS, QK_HEAD_DIM)
    q_nope = q[..., :QK_NOPE_DIM]
    q_rope = apply_rope(q[..., QK_NOPE_DIM:], cos[:, None, :], sin[:, None, :])
    kv = (rms_norm(c_kv, kv_norm_g) @ w_kv_up).reshape(b, s, N_HEADS, QK_NOPE_DIM + V_HEAD_DIM)
    k_nope = kv[..., :QK_NOPE_DIM]
    v = kv[..., QK_NOPE_DIM:]
    k_rope = apply_rope(k_rope_raw, cos, sin)
    y_a = latent_attention(q_nope, q_rope, k_nope, k_rope, v)
    return jnp.concatenate([y_f, y_a], axis=-1) @ w_out


def swiglu(xn, w_gate, w_up, w_down):
    return (jax.nn.silu(xn @ w_gate) * (xn @ w_up)) @ w_down


def setup_inputs(seed: int = 0) -> dict:
    key = jax.random.key(seed)
    ks = jax.random.split(key, 16)
    f32 = jnp.float32

    def w(k, shape, fan_in):
        return jax.random.normal(k, shape, f32) * (fan_in ** -0.5)

    def gain(k, shape):
        return 1.0 + 0.02 * jax.random.normal(k, shape, f32)

    return {
        "x_prompt": jax.random.normal(ks[0], (BATCH, SEQ, D_MODEL), f32),
        "x_sample": jax.random.normal(ks[1], (DEC_BATCH, DEC_SEQ, D_MODEL), f32),
        "norm_mix_g": gain(ks[2], (DEPTH, D_MODEL)),
        "w_in": w(ks[3], (DEPTH, D_MODEL, IN_WIDTH), D_MODEL),
        "q_norm_g": gain(ks[4], (DEPTH, Q_LORA_RANK)),
        "w_q_up": w(ks[5], (DEPTH, Q_LORA_RANK, N_HEADS * QK_HEAD_DIM), Q_LORA_RANK),
        "kv_norm_g": gain(ks[6], (DEPTH, KV_LORA_RANK)),
        "w_kv_up": w(ks[7], (DEPTH, KV_LORA_RANK, N_HEADS * (QK_NOPE_DIM + V_HEAD_DIM)), KV_LORA_RANK),
        "w_out": w(ks[8], (DEPTH, MIX_WIDTH, D_MODEL), MIX_WIDTH),
        "norm_ffn_g": gain(ks[9], (DEPTH, D_MODEL)),
        "w_gate": w(ks[10], (DEPTH, D_MODEL, D_FF), D_MODEL),
        "w_up": w(ks[11], (DEPTH, D_MODEL, D_FF), D_MODEL),
        "w_down": w(ks[12], (DEPTH, D_FF, D_MODEL), D_FF),
        "final_norm_g": gain(ks[13], (D_MODEL,)),
    }


def reference(x_prompt, x_sample, norm_mix_g, w_in, q_norm_g, w_q_up, kv_norm_g, w_kv_up, w_out,
              norm_ffn_g, w_gate, w_up, w_down, final_norm_g):
    def trunk(x):
        for l in range(DEPTH):
            x = x + token_mixer(rms_norm(x, norm_mix_g[l]), w_in[l], q_norm_g[l], w_q_up[l],
                                kv_norm_g[l], w_kv_up[l], w_out[l])
            x = x + swiglu(rms_norm(x, norm_ffn_g[l]), w_gate[l], w_up[l], w_down[l])
        return rms_norm(x, final_norm_g)

    y_prompt = trunk(x_prompt)
    y_sample = trunk(x_sample)
    return (y_prompt, y_sample)
```

```cpp
#include <hip/hip_runtime.h>
#include <hip/hip_cooperative_groups.h>
#include <cstdio>
#include <cstdint>
namespace cg = cooperative_groups;

#define LAS __attribute__((address_space(3)))
typedef unsigned short bf16_t;
typedef short bf16x8 __attribute__((ext_vector_type(8)));
typedef short s16x4 __attribute__((ext_vector_type(4)));
typedef float f32x4 __attribute__((ext_vector_type(4)));
typedef float f32x2 __attribute__((ext_vector_type(2)));
typedef float f32x16 __attribute__((ext_vector_type(16)));
typedef unsigned u32x4 __attribute__((ext_vector_type(4)));
typedef unsigned u32x2 __attribute__((ext_vector_type(2)));

constexpr int T = 98304, TP = 32768, SP = 8192, SS = 2048, DM = 1024, DFF = 2816;
constexpr float EPS = 1e-6f;
constexpr int KP = SP / 2 + 128, KS = SS / 2 + 128;
constexpr size_t MiB = 1u << 20;
constexpr size_t OFF_WIN = 0;
constexpr size_t OFF_WQ = OFF_WIN + 1280 * 1024 * 2;
constexpr size_t OFF_WKV = OFF_WQ + 1280 * 384 * 2;
constexpr size_t OFF_WOUT = OFF_WKV + 1536 * 256 * 2;
constexpr size_t OFF_WGU = OFF_WOUT + 1024 * 1024 * 2;
constexpr size_t OFF_WD = OFF_WGU + 5632 * 1024 * 2;
constexpr size_t OFF_ROPE = OFF_WD + 1024 * 2816 * 2;
constexpr size_t OFF_CQSSQ = OFF_ROPE + 8192 * 32 * 8;
constexpr size_t OFF_SSQ1 = OFF_CQSSQ + (size_t)T * 2 * 4;
constexpr size_t OFF_SSQ2 = OFF_SSQ1 + (size_t)T * 4 * 4;
constexpr size_t OFF_WEND = OFF_SSQ2 + (size_t)T * 4 * 4;
static_assert(OFF_WEND <= 32 * MiB, "weights region");
constexpr size_t OFF_XN = 32 * MiB;
constexpr size_t OFF_CQ = 224 * MiB;
constexpr size_t OFF_CKV = 296 * MiB;
constexpr size_t OFF_KR = 344 * MiB;
constexpr size_t OFF_DFTP = 356 * MiB;
constexpr size_t OFF_DFTS = 612 * MiB;
constexpr size_t OFF_UTFP = OFF_XN;
constexpr size_t OFF_UTFS = OFF_XN + 20 * MiB;
constexpr size_t OFF_PQP = 860 * MiB;
constexpr size_t OFF_PQS = 880 * MiB;
constexpr size_t OFF_UTP = 628 * MiB;
constexpr size_t OFF_UTS = 660 * MiB;
constexpr size_t OFF_Q = 356 * MiB;
constexpr size_t OFF_KN = 572 * MiB;
constexpr size_t OFF_V = 716 * MiB;
constexpr size_t OFF_X1B = 224 * MiB;
constexpr size_t OFF_H = 416 * MiB;
constexpr size_t OFF_BAR = 31 * MiB;
constexpr size_t OFF_CNT = OFF_BAR + 16384;
constexpr size_t WS_NEED = 944 * MiB;

struct Params {
  const float *x_prompt, *x_sample, *norm_mix_g, *w_in, *q_norm_g, *w_q_up, *kv_norm_g, *w_kv_up, *w_out, *norm_ffn_g, *w_gate, *w_up, *w_down, *final_g;
  float* out; char* ws;
};

typedef __bf16 bf16x2_t __attribute__((ext_vector_type(2)));
__device__ __forceinline__ unsigned cvt_pk_bf16(float lo, float hi) { const f32x2 v = {lo, hi}; return __builtin_bit_cast(unsigned, __builtin_convertvector(v, bf16x2_t)); }
__device__ __forceinline__ bf16_t f2bf(float x) { return (bf16_t)(cvt_pk_bf16(x, x) & 0xffffu); }
__device__ __forceinline__ u32x2 pack4(f32x4 v) { u32x2 w; w.x = cvt_pk_bf16(v[0], v[1]); w.y = cvt_pk_bf16(v[2], v[3]); return w; }
__device__ __forceinline__ int opaque_tid(int wid_k) { int l; asm volatile("v_mbcnt_lo_u32_b32 %0, -1, 0\n\tv_mbcnt_hi_u32_b32 %0, -1, %0" : "=v"(l)); return wid_k * 64 + l; }
__device__ __forceinline__ const float* xrow(const Params& p, int t) { return t < TP ? p.x_prompt + (size_t)t * DM : p.x_sample + (size_t)(t - TP) * DM; }


#define XB_TMO      128
#define XB_XCNT(j)  (256  + 64 * (j))
#define XB_XSUB(j)  (1280 + 64 * (j))
#define XB_XGEN(j)  (2304 + 64 * (j))
#define XB_TOP      3328
#define XB_TOPGEN   3392
#define XCD_BAR_WORDS 3456
#define XB_SPIN_CAP (1u << 18)
__device__ __forceinline__ unsigned xb_ld(unsigned* p)              { return __hip_atomic_load(p, __ATOMIC_RELAXED, __HIP_MEMORY_SCOPE_AGENT); }
__device__ __forceinline__ unsigned xb_add(unsigned* p, unsigned v) { return __hip_atomic_fetch_add(p, v, __ATOMIC_RELAXED, __HIP_MEMORY_SCOPE_AGENT); }
__device__ __forceinline__ unsigned xb_xcc_id() { return (unsigned)__builtin_amdgcn_s_getreg((3 << 11) | 20) & 0xFu; }
#define XB_SPIN(cond, bar) do { unsigned _sp = 0; while (cond) { __builtin_amdgcn_s_sleep(1); \
    if ((++_sp & 255u) == 0u) { if (xb_ld(&(bar)[XB_TMO])) break; if (_sp > XB_SPIN_CAP) { atomicAdd(&(bar)[XB_TMO], 1u); break; } } } } while (0)
struct XcdBarrier { unsigned* bar; unsigned x; volatile LAS unsigned* st; };
__device__ __forceinline__ XcdBarrier xcd_barrier_post(unsigned* bar, volatile LAS unsigned* st, int wid_k) {
  XcdBarrier b; b.bar = bar; b.x = xb_xcc_id(); b.st = st;
  if (opaque_tid(wid_k) == 0) (void)xb_add(&bar[XB_XCNT(b.x)], 1u);
  return b;
}
__device__ __forceinline__ void xcd_barrier_complete(unsigned* bar, unsigned x, unsigned& nloc, unsigned& nx) {
  const unsigned G = gridDim.x * gridDim.y * gridDim.z;
  unsigned sum, cnt, mine, sp = 0u;
  for (;;) {
    sum = 0u; cnt = 0u; mine = 0u;
#pragma unroll
    for (unsigned j = 0; j < 16; ++j) { const unsigned c = xb_ld(&bar[XB_XCNT(j)]); sum += c; cnt += (c > 0u) ? 1u : 0u; mine = (j == x) ? c : mine; }
    if (sum == G) break;
    __builtin_amdgcn_s_sleep(1);
    if ((++sp & 255u) == 0u) { if (xb_ld(&bar[XB_TMO])) break; if (sp > XB_SPIN_CAP) { atomicAdd(&bar[XB_TMO], 1u); break; } }
  }
  nloc = mine > 0u ? mine : 1u; nx = cnt > 0u ? cnt : 1u;
}
__device__ __forceinline__ void xcd_barrier(const XcdBarrier& b, int wid_k) {
  asm volatile("s_waitcnt vmcnt(0)" ::: "memory");
  __syncthreads();
  if (opaque_tid(wid_k) == 0) {
    unsigned* bar = b.bar;
    __builtin_amdgcn_s_waitcnt(0);
    unsigned nloc = b.st[0], nx = b.st[1];
    if (nloc == 0u) { xcd_barrier_complete(bar, b.x, nloc, nx); b.st[0] = nloc; b.st[1] = nx; }
    const unsigned old = xb_add(&bar[XB_XSUB(b.x)], 1u);
    const unsigned gen = old / nloc;
    if (old + 1u == (gen + 1u) * nloc) {
      __builtin_amdgcn_fence(__ATOMIC_RELEASE, "agent");
      asm volatile("s_waitcnt vmcnt(0)" ::: "memory");
      const unsigned og = xb_add(&bar[XB_TOP], 1u);
      const unsigned tg = og / nx;
      if (og + 1u == (tg + 1u) * nx) xb_add(&bar[XB_TOPGEN], 1u);
      else XB_SPIN(xb_ld(&bar[XB_TOPGEN]) == tg, bar);
      __builtin_amdgcn_fence(__ATOMIC_ACQUIRE, "agent");
      xb_add(&bar[XB_XGEN(b.x)], 1u);
      asm volatile("s_waitcnt vmcnt(0)" ::: "memory");
    } else {
      XB_SPIN(xb_ld(&bar[XB_XGEN(b.x)]) == gen, bar);
      __builtin_amdgcn_fence(__ATOMIC_ACQUIRE, "agent");
      asm volatile("s_waitcnt vmcnt(0)" ::: "memory");
    }
  }
  __syncthreads();
}

__device__ __forceinline__ void dft_gen(const Params& p, int bk, int nbk, int wid_k) {
  const int tid = opaque_tid(wid_k); char* ws = p.ws;
#pragma unroll
  for (int part = 0; part < 2; ++part) {
    const int S = part ? SS : SP, K = part ? KS : KP, R = part ? 1280 : 4352, cpr = 2 * K / 8;
    bf16_t* d = (bf16_t*)(ws + (part ? OFF_DFTS : OFF_DFTP));
    const float sc = part ? 0.022097086912079612f : 0.011048543456039806f, inv = 1.0f / (float)S;
    for (int g = bk * 512 + tid; g < R * cpr; g += nbk * 512) {
      const int k = g / cpr, c8 = (g % cpr) * 8, half = c8 >= K ? 1 : 0, s0 = c8 - half * K;
      int idx = (k * s0) & (S - 1); float v[8];
#pragma unroll
      for (int e = 0; e < 8; ++e) { const int sp = s0 + e; const float fr = (float)idx * inv;
        const bool ok = half ? (sp >= 1 && sp <= S / 2 - 1) : (sp <= S / 2);
        v[e] = ok ? sc * (half ? __builtin_amdgcn_sinf(fr) : __builtin_amdgcn_cosf(fr)) : 0.f; idx = (idx + k) & (S - 1); }
      u32x4 w = {cvt_pk_bf16(v[0], v[1]), cvt_pk_bf16(v[2], v[3]), cvt_pk_bf16(v[4], v[5]), cvt_pk_bf16(v[6], v[7])};
      *(u32x4*)(d + (size_t)k * (2 * K) + c8) = w;
    }
  }
}

struct FoldItem { u32x4 f, c1; unsigned m0; int s0, half; bf16_t* dst; };
__device__ __forceinline__ void fold_load(FoldItem& it, const bf16_t* __restrict__ ut, bf16_t* __restrict__ uf, int g, int S, int K) {
  const int cph = K / 8, row = g / (2 * cph), rem = g % (2 * cph); it.half = rem >= cph ? 1 : 0; it.s0 = (rem - it.half * cph) * 8;
  const bf16_t* U = ut + (size_t)row * (2 * S) + it.half * S;
  it.f = *(const u32x4*)(U + it.s0); it.c1 = *(const u32x4*)(U + S - it.s0 - 8); it.m0 = U[S - it.s0];
  it.dst = uf + (size_t)row * (2 * K) + it.half * K + it.s0;
}
__device__ __forceinline__ void fold_store(const FoldItem& it, int S) {
  const int H = S / 2; float F[8], C[8], M[8], o[8];
#pragma unroll
  for (int e = 0; e < 4; ++e) { F[2 * e] = __uint_as_float(it.f[e] << 16); F[2 * e + 1] = __uint_as_float(it.f[e] & 0xffff0000u); C[2 * e] = __uint_as_float(it.c1[e] << 16); C[2 * e + 1] = __uint_as_float(it.c1[e] & 0xffff0000u); }
  M[0] = __uint_as_float(it.m0 << 16);
#pragma unroll
  for (int e = 1; e < 8; ++e) M[e] = C[8 - e];
#pragma unroll
  for (int e = 0; e < 8; ++e) { const int sp = it.s0 + e; const bool mid = sp >= 1 && sp <= H - 1;
    o[e] = it.half ? (mid ? F[e] - M[e] : 0.f) : (mid ? F[e] + M[e] : ((sp == 0 || sp == H) ? F[e] : 0.f)); }
  *(u32x4*)it.dst = (u32x4){cvt_pk_bf16(o[0], o[1]), cvt_pk_bf16(o[2], o[3]), cvt_pk_bf16(o[4], o[5]), cvt_pk_bf16(o[6], o[7])};
}
__device__ __forceinline__ void dft_fold(const Params& p, int wid_k) {
  const int tid = opaque_tid(wid_k); char* ws = p.ws;
#pragma unroll
  for (int part = 0; part < 2; ++part) {
    const int S = part ? SS : SP, K = part ? KS : KP, NR = part ? 8192 : 1024, nitem = NR * 2 * (K / 8), stride = gridDim.x * 512;
    const bf16_t* ut = (const bf16_t*)(ws + (part ? OFF_UTS : OFF_UTP)); bf16_t* uf = (bf16_t*)(ws + (part ? OFF_UTFS : OFF_UTFP));
    for (int g = blockIdx.x * 512 + tid; g < nitem; g += 2 * stride) {
      FoldItem a, b; const bool hb = g + stride < nitem;
      fold_load(a, ut, uf, g, S, K); fold_load(b, ut, uf, hb ? g + stride : g, S, K);
      fold_store(a, S); if (hb) fold_store(b, S);
    }
  }
}

__device__ __forceinline__ bool wmap(const Params& p, int mat, int j, const float*& src, int& col, int& ld, const float*& gain) {
  switch (mat) {
    case 0: {
      src = p.w_in; ld = 960; gain = p.norm_mix_g;
      if (j < 768) { col = 640 + (j - 512); return true; }
      if (j < 1152) { col = 256 + (j - 768); return true; }
      if (j < 1216) { int q = j - 1152; col = 896 + ((q >> 2) & 1) * 32 + (q >> 5) * 16 + ((q >> 3) & 3) * 4 + (q & 3); return true; }
      return false; }
    case 1: {
      src = p.w_q_up; ld = 1152; gain = p.q_norm_g;
      int g = j >> 6; if (g >= 18) return false;
      if (g % 3 == 2) { int q = j & 63; col = (g / 3) * 192 + 128 + ((q >> 2) & 1) * 32 + (q >> 5) * 16 + ((q >> 3) & 3) * 4 + (q & 3); } else col = j;
      return true; }
    case 2: src = p.w_kv_up; ld = 1536; gain = p.kv_norm_g; col = j; return true;
    case 3: src = p.w_out; ld = 1024; gain = nullptr; col = j; return true;
    case 4: { int tile = j >> 8, half = (j >> 7) & 1; src = half ? p.w_up : p.w_gate; ld = DFF; gain = p.norm_ffn_g; col = tile * 128 + (j & 127); return true; }
    default: src = p.w_down; ld = 1024; gain = nullptr; col = j; return true;
  }
}

__device__ __forceinline__ void wprep(const Params& p, LAS char* lds, int mat0, int mat1, int bid, int nb, int wid_k) {
  const int tid = opaque_tid(wid_k); char* ws = p.ws;
  __syncthreads();
  {
    LAS float* tl = (LAS float*)lds;
    const int nrows[6] = {768, 1280, 1536, 1024, 5632, 1024}, kk_[6] = {1024, 384, 256, 1024, 1024, 2816}, row0[6] = {512, 0, 0, 0, 0, 0};
    const size_t offs[6] = {OFF_WIN, OFF_WQ, OFF_WKV, OFF_WOUT, OFF_WGU, OFF_WD};
    int job = bid;
#pragma unroll
    for (int mat = 0; mat < 6; ++mat) {
      if (mat < mat0 || mat >= mat1) continue;
      const int K = kk_[mat], ntk = K / 64, ntiles = (nrows[mat] / 64) * ntk;
      bf16_t* dst = (bf16_t*)(ws + offs[mat]);
      for (; job < ntiles; job += nb) {
        const int j0 = row0[mat] + (job / ntk) * 64, k0 = (job % ntk) * 64;
        { const int kk = tid >> 3, jj0 = (tid & 7) * 8; const float* src; int col, ld; const float* gain;
          f32x4 a = {0.f, 0.f, 0.f, 0.f}, b = a;
          if (wmap(p, mat, j0 + jj0, src, col, ld, gain)) { a = *(const f32x4*)(src + (size_t)(k0 + kk) * ld + col); if (gain) a = a * gain[k0 + kk]; }
          if (wmap(p, mat, j0 + jj0 + 4, src, col, ld, gain)) { b = *(const f32x4*)(src + (size_t)(k0 + kk) * ld + col); if (gain) b = b * gain[k0 + kk]; }
#pragma unroll
          for (int e = 0; e < 4; ++e) { tl[kk * 65 + jj0 + e] = a[e]; tl[kk * 65 + jj0 + 4 + e] = b[e]; } }
        __syncthreads();
        { const int jj = tid >> 3, kk0 = (tid & 7) * 8; float v[8];
#pragma unroll
          for (int e = 0; e < 8; ++e) v[e] = tl[(kk0 + e) * 65 + jj];
          u32x4 w = {cvt_pk_bf16(v[0], v[1]), cvt_pk_bf16(v[2], v[3]), cvt_pk_bf16(v[4], v[5]), cvt_pk_bf16(v[6], v[7])};
          *(u32x4*)(dst + (size_t)(j0 + jj) * K + k0 + kk0) = w; }
        __syncthreads();
      }
      job -= ntiles;
    }
  }
}


__device__ __forceinline__ void phaseA(const Params& p, LAS char* lds, int wid_k) {
  const int tid = opaque_tid(wid_k), bid = blockIdx.x, nb = gridDim.x, wid = tid >> 6, lane = tid & 63;
  char* ws = p.ws;
  {
    bf16_t* xn = (bf16_t*)(ws + OFF_XN);
    for (int t = (bid * 8 + wid) * 4; t < T; t += nb * 32) {
      f32x4 v[4][4]; float ss[4];
#pragma unroll
      for (int r = 0; r < 4; ++r) { const float* src = xrow(p, t + r);
#pragma unroll
        for (int i = 0; i < 4; ++i) v[r][i] = *(const f32x4*)(src + i * 256 + lane * 4); }
#pragma unroll
      for (int r = 0; r < 4; ++r) { float a = 0.f;
#pragma unroll
        for (int i = 0; i < 4; ++i) a += v[r][i][0] * v[r][i][0] + v[r][i][1] * v[r][i][1] + v[r][i][2] * v[r][i][2] + v[r][i][3] * v[r][i][3];
        ss[r] = a; }
#pragma unroll
      for (int o = 32; o >= 1; o >>= 1) {
#pragma unroll
        for (int r = 0; r < 4; ++r) ss[r] += __shfl_xor(ss[r], o); }
#pragma unroll
      for (int r = 0; r < 4; ++r) { const float rs = __builtin_amdgcn_rsqf(ss[r] * (1.0f / DM) + EPS);
#pragma unroll
        for (int i = 0; i < 4; ++i) *(u32x2*)(xn + (size_t)(t + r) * DM + i * 256 + lane * 4) = pack4(v[r][i] * rs); }
    }
  }
  {
    f32x2* tab = (f32x2*)(ws + OFF_ROPE);
    for (int g = bid * 512 + tid; g < 8192 * 32; g += nb * 512) {
      const int pos = g >> 5, i = g & 31;
      double f = 0.15915494309189535;
      const double r = 0.74989420933245582;
      for (int e = 0; e < i; ++e) f *= r;
      double a = (double)pos * f; a -= __builtin_floor(a);
      const float fr = (float)a;
      tab[g] = (f32x2){__builtin_amdgcn_cosf(fr), __builtin_amdgcn_sinf(fr)};
    }
  }
  {
    LAS float* ctab = (LAS float*)lds;
    if (tid < 64) ctab[tid] = __builtin_amdgcn_cosf((float)tid * (1.0f / 64.0f));
    __syncthreads();
    bf16_t* wt = (bf16_t*)(ws + OFF_WIN);
    for (int g = bid * 512 + tid; g < 512 * 1024; g += nb * 512) {
      const int j = g >> 10, k = g & 1023, part = j >> 8, grp = (j >> 6) & 3, cp = j & 63;
      const float* src = p.w_in + (size_t)k * 960 + grp * 64; float a = 0.f;
      for (int c = 0; c < 64; c += 4) { const f32x4 w = *(const f32x4*)(src + c);
#pragma unroll
        for (int e = 0; e < 4; ++e) a += w[e] * ctab[((c + e) * cp + part * 16) & 63]; }
      wt[(size_t)j * 1024 + k] = f2bf(a * 0.125f * p.norm_mix_g[k]);
    }
    __syncthreads();
  }
  wprep(p, lds, 0, 3, bid, nb, wid_k);
}

constexpr int BK = 64, HTB = 128 * 64 * 2;
__device__ __forceinline__ int lds_byte(int r, int c) { const int st = (r >> 4) * 2 + (c >> 5), rr = r & 15, cc = c & 31, ob = rr * 64 + cc * 2; return st * 1024 + (ob ^ (((ob >> 9) & 1) << 5)); }
__device__ __forceinline__ void stage_rc(int b, int& R, int& C) { const int st = b / 1024, sb = b % 1024, swz = sb ^ (((sb >> 9) & 1) << 5); R = (st >> 1) * 16 + swz / 64; C = (st & 1) * 32 + (swz % 64) / 2; }

struct Unit { const bf16_t* A; const bf16_t* Bt; int lda, ldb, K, epi, pm, pn; };
enum { E_G1 = 0, E_DFT, E_Q, E_KV, E_OUT, E_GU, E_DOWN };

typedef f32x4 Acc[2][2][4][2];

template <int BJ0, int BJ1>
__device__ __forceinline__ void row_ssq_to_lds(const Acc& acc, LAS float* P, int wr, int wc, int fr, int fq) {
#pragma unroll
  for (int ai = 0; ai < 2; ++ai)
#pragma unroll
    for (int m = 0; m < 4; ++m) {
      float s = 0.f;
#pragma unroll
      for (int bj = BJ0; bj < BJ1; ++bj)
#pragma unroll
        for (int n = 0; n < 2; ++n) { const f32x4 x = acc[ai][bj][m][n]; s += (x[0] * x[0] + x[1] * x[1]) + (x[2] * x[2] + x[3] * x[3]); }
      { auto r16 = __builtin_amdgcn_permlane16_swap(__float_as_uint(s), __float_as_uint(s), false, false); s = __uint_as_float(r16[0]) + __uint_as_float(r16[1]); }
      { auto r32 = __builtin_amdgcn_permlane32_swap(__float_as_uint(s), __float_as_uint(s), false, false); s = __uint_as_float(r32[0]) + __uint_as_float(r32[1]); }
      if (fq == 0) P[(ai * 128 + wr * 64 + m * 16 + fr) * 4 + wc] = s;
    }
}

__device__ __forceinline__ u32x4 pack8(f32x4 a, f32x4 b) { u32x4 w; w.x = cvt_pk_bf16(a[0], a[1]); w.y = cvt_pk_bf16(a[2], a[3]); w.z = cvt_pk_bf16(b[0], b[1]); w.w = cvt_pk_bf16(b[2], b[3]); return w; }
template <int EPI>
__device__ __forceinline__ void epilogue(const Params& p, const Unit& u, Acc& acc, LAS char* lds, int tid, int wr, int wc, int fr, int fq) {
  char* ws = p.ws;
  const int brow = u.pm * 256;
  LAS float* P = (LAS float*)(lds + 8 * HTB);
  const int rl0 = wr * 64 + fr;
  const int cl0 = wc * 32 + fq * 8;
  switch (EPI) {
    case E_G1: {
      const int pn = u.pn;
      if (pn < 2) {
        const bool prm = brow < TP; const int S = prm ? SP : SS, tt = prm ? brow : brow - TP, b = tt / S, s0 = tt % S;
        bf16_t* base = (bf16_t*)(ws + (prm ? OFF_UTP : OFF_UTS)) + (size_t)(b * 256) * (2 * S) + pn * S + s0;
        const size_t ldu = 2 * S;
#pragma unroll
        for (int ai = 0; ai < 2; ++ai)
#pragma unroll
          for (int m = 0; m < 4; ++m)
#pragma unroll
            for (int bj = 0; bj < 2; ++bj) *(u32x4*)(base + (size_t)(ai * 128 + rl0 + m * 16) * ldu + bj * 128 + cl0) = pack8(acc[ai][bj][m][0], acc[ai][bj][m][1]);
      } else if (pn == 2) {
        row_ssq_to_lds<0, 2>(acc, P, wr, wc, fr, fq);
        __syncthreads();
        bf16_t* o = (bf16_t*)(ws + OFF_CKV);
#pragma unroll
        for (int ai = 0; ai < 2; ++ai)
#pragma unroll
          for (int m = 0; m < 4; ++m) {
            const int rl = ai * 128 + rl0 + m * 16; const f32x4 q = *(LAS f32x4*)(P + rl * 4);
            const float rs = __builtin_amdgcn_rsqf(((q[0] + q[1]) + (q[2] + q[3])) * (1.0f / 256.0f) + EPS);
#pragma unroll
            for (int bj = 0; bj < 2; ++bj) *(u32x4*)(o + (size_t)(brow + rl) * 256 + bj * 128 + cl0) = pack8(acc[ai][bj][m][0] * rs, acc[ai][bj][m][1] * rs);
          }
      } else if (pn == 3) {
        row_ssq_to_lds<0, 2>(acc, P, wr, wc, fr, fq);
        __syncthreads();
        if (tid < 256) { const f32x4 q = *(LAS f32x4*)(P + tid * 4); ((float*)(ws + OFF_CQSSQ))[(size_t)(brow + tid) * 2 + 0] = (q[0] + q[1]) + (q[2] + q[3]); }
        bf16_t* o = (bf16_t*)(ws + OFF_CQ);
#pragma unroll
        for (int ai = 0; ai < 2; ++ai)
#pragma unroll
          for (int m = 0; m < 4; ++m)
#pragma unroll
            for (int bj = 0; bj < 2; ++bj) *(u32x4*)(o + (size_t)(brow + ai * 128 + rl0 + m * 16) * 384 + bj * 128 + cl0) = pack8(acc[ai][bj][m][0], acc[ai][bj][m][1]);
      } else {
        row_ssq_to_lds<0, 1>(acc, P, wr, wc, fr, fq);
        __syncthreads();
        if (tid < 256) { const f32x4 q = *(LAS f32x4*)(P + tid * 4); ((float*)(ws + OFF_CQSSQ))[(size_t)(brow + tid) * 2 + 1] = (q[0] + q[1]) + (q[2] + q[3]); }
        bf16_t* o = (bf16_t*)(ws + OFF_CQ);
        bf16_t* kr = (bf16_t*)(ws + OFF_KR);
        const f32x2* tab = (const f32x2*)(ws + OFF_ROPE);
        const bool prm = brow < TP; const int S = prm ? SP : SS, pos0 = (prm ? brow : brow - TP) & (S - 1);
#pragma unroll
        for (int ai = 0; ai < 2; ++ai)
#pragma unroll
          for (int m = 0; m < 4; ++m) {
            const int rl = ai * 128 + rl0 + m * 16;
            *(u32x4*)(o + (size_t)(brow + rl) * 384 + 256 + cl0) = pack8(acc[ai][0][m][0], acc[ai][0][m][1]);
            if (wc < 2) {
              const int i0 = wc * 16 + fq * 4; const f32x2* tp = tab + (size_t)(pos0 + rl) * 32 + i0;
              f32x4 lo, hi; const f32x4 x1 = acc[ai][1][m][0], x2 = acc[ai][1][m][1];
#pragma unroll
              for (int j = 0; j < 4; ++j) { const f32x2 cs = tp[j]; lo[j] = x1[j] * cs.x - x2[j] * cs.y; hi[j] = x2[j] * cs.x + x1[j] * cs.y; }
              *(u32x2*)(kr + (size_t)(brow + rl) * 64 + i0) = pack4(lo); *(u32x2*)(kr + (size_t)(brow + rl) * 64 + 32 + i0) = pack4(hi);
            }
          }
      }
    } break;
    case E_DFT: {
      bf16_t* o = (bf16_t*)(ws + (u.pm ? OFF_PQS : OFF_PQP)) + (size_t)u.pn * 256;
#pragma unroll
      for (int ai = 0; ai < 2; ++ai)
#pragma unroll
        for (int m = 0; m < 4; ++m)
#pragma unroll
          for (int bj = 0; bj < 2; ++bj) *(u32x4*)(o + (size_t)(ai * 128 + rl0 + m * 16) * 256 + bj * 128 + cl0) = pack8(acc[ai][bj][m][0], acc[ai][bj][m][1]);
    } break;
    case E_Q: {
      bf16_t* o = (bf16_t*)(ws + OFF_Q);
      const f32x2* tab = (const f32x2*)(ws + OFF_ROPE);
      const float* ssq = (const float*)(ws + OFF_CQSSQ);
      const bool prm = brow < TP; const int S = prm ? SP : SS, pos0 = (prm ? brow : brow - TP) & (S - 1);
      const float QS = 0.07216878364870322f * 1.4426950408889634f;
#pragma unroll
      for (int ai = 0; ai < 2; ++ai)
#pragma unroll
        for (int m = 0; m < 4; ++m) {
          const int rl = ai * 128 + rl0 + m * 16; const f32x2 sq = *(const f32x2*)(ssq + (size_t)(brow + rl) * 2);
          const float rs = __builtin_amdgcn_rsqf((sq.x + sq.y) * (1.0f / 384.0f) + EPS) * QS;
#pragma unroll
          for (int bj = 0; bj < 2; ++bj) {
            const int g = u.pn * 4 + bj * 2 + (wc >> 1);
            if (g >= 18) continue;
            if (g % 3 == 2) {
              const int i0 = (wc & 1) * 16 + fq * 4; const f32x2* tp = tab + (size_t)(pos0 + rl) * 32 + i0;
              f32x4 lo, hi; const f32x4 x1 = acc[ai][bj][m][0] * rs, x2 = acc[ai][bj][m][1] * rs;
#pragma unroll
              for (int j = 0; j < 4; ++j) { const f32x2 cs = tp[j]; lo[j] = x1[j] * cs.x - x2[j] * cs.y; hi[j] = x2[j] * cs.x + x1[j] * cs.y; }
              bf16_t* q = o + (size_t)(brow + rl) * 1152 + g * 64 + i0;
              *(u32x2*)q = pack4(lo); *(u32x2*)(q + 32) = pack4(hi);
            } else {
              *(u32x4*)(o + (size_t)(brow + rl) * 1152 + u.pn * 256 + bj * 128 + cl0) = pack8(acc[ai][bj][m][0] * rs, acc[ai][bj][m][1] * rs);
            }
          }
        }
    } break;
    case E_KV: {
      bf16_t* ok = (bf16_t*)(ws + OFF_KN); bf16_t* ov = (bf16_t*)(ws + OFF_V);
#pragma unroll
      for (int ai = 0; ai < 2; ++ai)
#pragma unroll
        for (int m = 0; m < 4; ++m) {
          const size_t ro = (size_t)(brow + ai * 128 + rl0 + m * 16) * 768 + u.pn * 128 + cl0;
          *(u32x4*)(ok + ro) = pack8(acc[ai][0][m][0], acc[ai][0][m][1]); *(u32x4*)(ov + ro) = pack8(acc[ai][1][m][0], acc[ai][1][m][1]);
        }
    } break;
    case E_OUT: {
      const float* xb = xrow(p, brow); bf16_t* ob = (bf16_t*)(ws + OFF_X1B) + (size_t)brow * DM;
      f32x4 ra[2][2][2], rb[2][2][2];
#define EO_LOAD(R, B) do { _Pragma("unroll") for (int m = 0; m < 2; ++m) _Pragma("unroll") for (int bj = 0; bj < 2; ++bj) _Pragma("unroll") for (int n = 0; n < 2; ++n) \
        R[m][bj][n] = *(const f32x4*)(xb + (size_t)(((B) >> 1) * 128 + rl0 + (((B) & 1) * 2 + m) * 16) * DM + u.pn * 256 + bj * 128 + cl0 + n * 4); } while (0)
#define EO_PROC(R, B) do { _Pragma("unroll") for (int m = 0; m < 2; ++m) _Pragma("unroll") for (int bj = 0; bj < 2; ++bj) { const int ai_ = (B) >> 1, mm_ = ((B) & 1) * 2 + m; \
        const size_t off = (size_t)(ai_ * 128 + rl0 + mm_ * 16) * DM + u.pn * 256 + bj * 128 + cl0; \
        const f32x4 v0 = acc[ai_][bj][mm_][0] + R[m][bj][0], v1 = acc[ai_][bj][mm_][1] + R[m][bj][1]; acc[ai_][bj][mm_][0] = v0; acc[ai_][bj][mm_][1] = v1; \
        *(u32x4*)(ob + off) = pack8(v0, v1); } } while (0)
#define EO_FENCE() do { asm volatile("" ::: "memory"); __builtin_amdgcn_sched_barrier(0); } while (0)
      EO_LOAD(ra, 0); EO_LOAD(rb, 1); EO_FENCE();
      EO_PROC(ra, 0); EO_FENCE(); EO_LOAD(ra, 2); EO_FENCE();
      EO_PROC(rb, 1); EO_FENCE(); EO_LOAD(rb, 3); EO_FENCE();
      EO_PROC(ra, 2); EO_FENCE();
      EO_PROC(rb, 3); EO_FENCE();
#undef EO_LOAD
#undef EO_PROC
      row_ssq_to_lds<0, 2>(acc, P, wr, wc, fr, fq);
      __syncthreads();
      if (tid < 256) { const f32x4 q = *(LAS f32x4*)(P + tid * 4); ((float*)(ws + OFF_SSQ1))[(size_t)(brow + tid) * 4 + u.pn] = (q[0] + q[1]) + (q[2] + q[3]); }
    } break;
    case E_GU: {
      bf16_t* o = (bf16_t*)(ws + OFF_H);
      const float* ssq = (const float*)(ws + OFF_SSQ1);
#pragma unroll
      for (int ai = 0; ai < 2; ++ai)
#pragma unroll
        for (int m = 0; m < 4; ++m) {
          const int rl = ai * 128 + rl0 + m * 16; const f32x4 sq = *(const f32x4*)(ssq + (size_t)(brow + rl) * 4);
          const float rs = __builtin_amdgcn_rsqf(((sq[0] + sq[1]) + (sq[2] + sq[3])) * (1.0f / DM) + EPS);
          const float rsl = rs * -1.4426950408889634f; u32x4 w;
#pragma unroll
          for (int n = 0; n < 2; ++n)
#pragma unroll
            for (int jp = 0; jp < 2; ++jp) {
              const f32x2 a0 = {acc[ai][0][m][n][2 * jp], acc[ai][0][m][n][2 * jp + 1]}, a1 = {acc[ai][1][m][n][2 * jp], acc[ai][1][m][n][2 * jp + 1]};
              const f32x2 g = a0 * rs, uu = a1 * rs, e2 = a0 * rsl;
              const f32x2 d = (f32x2){__builtin_amdgcn_exp2f(e2.x), __builtin_amdgcn_exp2f(e2.y)} + 1.0f;
              const f32x2 hh = (g * uu) * (f32x2){__builtin_amdgcn_rcpf(d.x), __builtin_amdgcn_rcpf(d.y)};
              w[n * 2 + jp] = cvt_pk_bf16(hh.x, hh.y); }
          *(u32x4*)(o + (size_t)(brow + rl) * DFF + u.pn * 128 + cl0) = w;
        }
    } break;
    default: {
      float* o = p.out + (size_t)brow * DM; const bf16_t* x1b = (const bf16_t*)(ws + OFF_X1B) + (size_t)brow * DM;
      u32x4 ra[2][2], rb[2][2];
#define ED_LOAD(R, B) do { _Pragma("unroll") for (int m = 0; m < 2; ++m) _Pragma("unroll") for (int bj = 0; bj < 2; ++bj) \
        R[m][bj] = *(const u32x4*)(x1b + (size_t)(((B) >> 1) * 128 + rl0 + (((B) & 1) * 2 + m) * 16) * DM + u.pn * 256 + bj * 128 + cl0); } while (0)
#define ED_PROC(R, B) do { _Pragma("unroll") for (int m = 0; m < 2; ++m) _Pragma("unroll") for (int bj = 0; bj < 2; ++bj) { const int ai_ = (B) >> 1, mm_ = ((B) & 1) * 2 + m; const u32x4 w = R[m][bj]; \
        acc[ai_][bj][mm_][0] = acc[ai_][bj][mm_][0] + (f32x4){__uint_as_float(w.x << 16), __uint_as_float(w.x & 0xffff0000u), __uint_as_float(w.y << 16), __uint_as_float(w.y & 0xffff0000u)}; \
        acc[ai_][bj][mm_][1] = acc[ai_][bj][mm_][1] + (f32x4){__uint_as_float(w.z << 16), __uint_as_float(w.z & 0xffff0000u), __uint_as_float(w.w << 16), __uint_as_float(w.w & 0xffff0000u)}; } } while (0)
      ED_LOAD(ra, 0); ED_LOAD(rb, 1); EO_FENCE();
      ED_PROC(ra, 0); EO_FENCE(); ED_LOAD(ra, 2); EO_FENCE();
      ED_PROC(rb, 1); EO_FENCE(); ED_LOAD(rb, 3); EO_FENCE();
      ED_PROC(ra, 2); ED_PROC(rb, 3); EO_FENCE();
#undef ED_LOAD
#undef ED_PROC
      row_ssq_to_lds<0, 2>(acc, P, wr, wc, fr, fq);
      __syncthreads();
      float* ssq = (float*)(ws + OFF_SSQ2);
      unsigned* cnt = (unsigned*)(ws + OFF_CNT) + u.pm * 16;
      if (tid < 256) { const f32x4 q = *(LAS f32x4*)(P + tid * 4);
        __hip_atomic_store(ssq + (size_t)(brow + tid) * 4 + u.pn, (q[0] + q[1]) + (q[2] + q[3]), __ATOMIC_RELAXED, __HIP_MEMORY_SCOPE_AGENT);
        asm volatile("s_waitcnt vmcnt(0)" ::: "memory");
        if ((tid & 63) == 0) __hip_atomic_fetch_add(cnt, 1u, __ATOMIC_RELAXED, __HIP_MEMORY_SCOPE_AGENT); }
      if (__builtin_amdgcn_readfirstlane(tid >> 6) == 0) {
        unsigned spins = 0;
        while ((unsigned)__builtin_amdgcn_readfirstlane(__hip_atomic_load(cnt, __ATOMIC_RELAXED, __HIP_MEMORY_SCOPE_AGENT)) < 16u) { __builtin_amdgcn_s_sleep(2); if (++spins > (1u << 22)) break; }
        __builtin_amdgcn_fence(__ATOMIC_ACQUIRE, "agent");
      }
      asm volatile("s_waitcnt vmcnt(0) lgkmcnt(0)" ::: "memory");
      __syncthreads();
      asm volatile("" ::: "memory"); __builtin_amdgcn_sched_barrier(0);
      int rl0b = rl0, cl0b = cl0; asm volatile("" : "+v"(rl0b), "+v"(cl0b));
      const float* fg = p.final_g + u.pn * 256 + cl0b;
      f32x4 gv[2][2];
#pragma unroll
      for (int bj = 0; bj < 2; ++bj)
#pragma unroll
        for (int n = 0; n < 2; ++n) gv[bj][n] = *(const f32x4*)(fg + bj * 128 + n * 4);
#pragma unroll
      for (int ai = 0; ai < 2; ++ai)
#pragma unroll
        for (int m = 0; m < 4; ++m) {
          const int rl = ai * 128 + rl0b + m * 16;
          const f32x4 sq4 = *(const volatile f32x4*)(ssq + (size_t)(brow + rl) * 4);
          const float rs = __builtin_amdgcn_rsqf(((sq4[0] + sq4[1]) + (sq4[2] + sq4[3])) * (1.0f / DM) + EPS);
#pragma unroll
          for (int bj = 0; bj < 2; ++bj) { const size_t off = (size_t)rl * DM + u.pn * 256 + bj * 128 + cl0b;
            *(f32x4*)(o + off) = acc[ai][bj][m][0] * rs * gv[bj][0]; *(f32x4*)(o + off + 4) = acc[ai][bj][m][1] * rs * gv[bj][1]; }
          if (m & 1) { asm volatile("" ::: "memory"); __builtin_amdgcn_sched_barrier(0); }
        }
    } break;
  }
}

__device__ __forceinline__ bool reg_map(int NU, int nN, int c, int i, int& pm, int& pn, int& idx_out) {
  const int xcd = c & 7, l = c >> 3, chunk = (NU + 7) >> 3, li = i * 32 + l, idx = xcd * chunk + li;
  if (li >= chunk || idx >= NU) return false;
  const int nig = 8 * nN, gid = idx / nig, r = idx % nig;
  pm = gid * 8 + (r & 7); pn = r >> 3; idx_out = idx; return true;
}
__device__ __forceinline__ bool get_unit(const Params& p, int ph, int c, int i, Unit& u) {
  char* ws = p.ws; int pm, pn, idx;
  switch (ph) {
    case 1: if (!reg_map(384 * 5, 5, c, i, pm, pn, idx)) return false;
      u.A = (const bf16_t*)(ws + OFF_XN) + (size_t)pm * 256 * 1024; u.lda = 1024; u.Bt = (const bf16_t*)(ws + OFF_WIN) + (size_t)pn * 256 * 1024; u.ldb = 1024; u.K = 1024; u.epi = E_G1; u.pm = pm; u.pn = pn;
      if (pn < 2) { const bf16_t* t = u.A; u.A = u.Bt; u.Bt = t; }
      return true;
    case 2: {
      const int xcd = c & 7, l = c >> 3;
      if (l < 17) { if (i > 0) return false;
        const int un = xcd * 17 + l, type = un / 68, r = un % 68, b = r & 3; pm = r >> 2;
        u.A = (const bf16_t*)(ws + OFF_DFTP) + (size_t)pm * 256 * (2 * KP) + type * KP; u.lda = 2 * KP; u.Bt = (const bf16_t*)(ws + OFF_UTFP) + (size_t)b * 256 * (2 * KP) + type * KP; u.ldb = 2 * KP; u.K = KP;
        u.pn = (type * 4 + b) * 4352 + pm * 256; u.pm = 0; }
      else { const int li = (l - 17) + 15 * i; if (li >= 40) return false;
        const int su = xcd * 40 + li, type = su / 160, r = su % 160, b = r / 5; pm = r % 5;
        u.A = (const bf16_t*)(ws + OFF_DFTS) + (size_t)pm * 256 * (2 * KS) + type * KS; u.lda = 2 * KS; u.Bt = (const bf16_t*)(ws + OFF_UTFS) + (size_t)b * 256 * (2 * KS) + type * KS; u.ldb = 2 * KS; u.K = KS;
        u.pn = (type * 32 + b) * 1280 + pm * 256; u.pm = 1; }
      u.epi = E_DFT; return true; }
    case 3: {
      const int NU = 384 * 11, xcd = c & 7, l = c >> 3, chunk = NU / 8, li = i * 32 + l; idx = xcd * chunk + li;
      if (li >= chunk) return false;
      const int gid = idx / 88, r = idx % 88; pm = gid * 8 + (r & 7); pn = r >> 3;
      if (pn < 5) { u.A = (const bf16_t*)(ws + OFF_CQ) + (size_t)pm * 256 * 384; u.lda = 384; u.Bt = (const bf16_t*)(ws + OFF_WQ) + (size_t)pn * 256 * 384; u.ldb = 384; u.K = 384; u.epi = E_Q; u.pn = pn; }
      else { pn -= 5; u.A = (const bf16_t*)(ws + OFF_CKV) + (size_t)pm * 256 * 256; u.lda = 256; u.Bt = (const bf16_t*)(ws + OFF_WKV) + (size_t)pn * 256 * 256; u.ldb = 256; u.K = 256; u.epi = E_KV; u.pn = pn; }
      u.pm = pm; return true; }
    case 4: if (!reg_map(384 * 4, 4, c, i, pm, pn, idx)) return false;
      u.A = (const bf16_t*)(ws + OFF_XN) + (size_t)pm * 256 * 1024; u.lda = 1024; u.Bt = (const bf16_t*)(ws + OFF_WOUT) + (size_t)pn * 256 * 1024; u.ldb = 1024; u.K = 1024; u.epi = E_OUT; u.pm = pm; u.pn = pn; return true;
    case 5: if (!reg_map(384 * 22, 22, c, i, pm, pn, idx)) return false;
      u.A = (const bf16_t*)(ws + OFF_X1B) + (size_t)pm * 256 * 1024; u.lda = 1024; u.Bt = (const bf16_t*)(ws + OFF_WGU) + (size_t)pn * 256 * 1024; u.ldb = 1024; u.K = 1024; u.epi = E_GU; u.pm = pm; u.pn = pn; return true;
    default: if (!reg_map(384 * 4, 4, c, i, pm, pn, idx)) return false;
      u.A = (const bf16_t*)(ws + OFF_H) + (size_t)pm * 256 * DFF; u.lda = DFF; u.Bt = (const bf16_t*)(ws + OFF_WD) + (size_t)pn * 256 * DFF; u.ldb = DFF; u.K = DFF; u.epi = E_DOWN; u.pm = pm; u.pn = pn; return true;
  }
}

__device__ __forceinline__ void dft_combine(const Params& p, int wid_k) {
  const int tid = opaque_tid(wid_k);
  char* ws = p.ws; bf16_t* cat = (bf16_t*)(ws + OFF_XN);
#pragma unroll
  for (int part = 0; part < 2; ++part) {
    const int S = part ? SS : SP, NB = part ? 32 : 4, RP = part ? 1280 : 4352, H = S / 2, t0 = part ? TP : 0;
    const bf16_t* pq = (const bf16_t*)(ws + (part ? OFF_PQS : OFF_PQP));
    const int nitem = NB * (H + 1) * 32, stride = gridDim.x * 512;
    for (int g0 = blockIdx.x * 512 + tid; g0 < nitem; g0 += 4 * stride) {
      u32x4 pw[4], qw[4];
#pragma unroll
      for (int i = 0; i < 4; ++i) { const int g = g0 + i * stride < nitem ? g0 + i * stride : g0; const int c8 = (g & 31) * 8, r = g >> 5, b = r / (H + 1), k = r % (H + 1);
        pw[i] = *(const u32x4*)(pq + ((size_t)(0 * NB + b) * RP + k) * 256 + c8); qw[i] = *(const u32x4*)(pq + ((size_t)(1 * NB + b) * RP + k) * 256 + c8); }
#pragma unroll
      for (int i = 0; i < 4; ++i) { const int g = g0 + i * stride; if (g >= nitem) break;
        const int c8 = (g & 31) * 8, r = g >> 5, b = r / (H + 1), k = r % (H + 1);
        u32x4 ys, yd;
#pragma unroll
        for (int e = 0; e < 4; ++e) { const float p0 = __uint_as_float(pw[i][e] << 16), p1 = __uint_as_float(pw[i][e] & 0xffff0000u), q0 = __uint_as_float(qw[i][e] << 16), q1 = __uint_as_float(qw[i][e] & 0xffff0000u);
          ys[e] = cvt_pk_bf16(p0 + q0, p1 + q1); yd[e] = cvt_pk_bf16(p0 - q0, p1 - q1); }
        *(u32x4*)(cat + (size_t)(t0 + b * S + k) * DM + c8) = ys;
        if (k > 0 && k < H) *(u32x4*)(cat + (size_t)(t0 + b * S + S - k) * DM + c8) = yd; }
    }
  }
}

template <int PH>
__device__ __forceinline__ void gemm_phase(const Params& p, LAS char* lds, int wid_k) {
  const int tid = opaque_tid(wid_k), wid = __builtin_amdgcn_readfirstlane(tid >> 6), lane = tid & 63, wr = wid >> 2, wc = wid & 3, fr = lane & 15, fq = lane >> 4;
  Unit u, nx;
  bool have = get_unit(p, PH, blockIdx.x, 0, u);
  if (!have) return;
  unsigned voffA[2], voffB[2]; const char *gA0, *gA1, *gB0, *gB1;
#define G_SETUP(U) do { int t2_ = opaque_tid(wid_k); _Pragma("unroll") for (int i_ = 0; i_ < 2; ++i_) { int sR_, sC_; stage_rc(t2_ * 16 + i_ * 8192, sR_, sC_); \
      const int rho_ = sR_ & 31, sRb_ = (sR_ & ~31) + 8 * ((rho_ & 15) >> 2) + 4 * (rho_ >> 4) + (rho_ & 3); \
      voffA[i_] = (unsigned)(sR_ * (U).lda + sC_) * 2u; voffB[i_] = (unsigned)(sRb_ * (U).ldb + sC_) * 2u; } \
    gA0 = (const char*)(U).A; gA1 = gA0 + (size_t)128 * (U).lda * 2; gB0 = (const char*)(U).Bt; gB1 = gB0 + (size_t)128 * (U).ldb * 2; } while (0)
  const unsigned ldsw = (unsigned)wid * 1024u;
  const int aoff = lds_byte(wr * 64 + fr, fq * 8), boff = lds_byte(wc * 32 + fr, fq * 8);
#define G_SA(b, h) (((b) * 2 + (h)) * HTB)
#define G_SB(b, h) ((4 + (b) * 2 + (h)) * HTB)
#define G_STAGE(bufoff, gbase, voff, kt) do { _Pragma("unroll") for (int _i = 0; _i < 2; ++_i) \
    __builtin_amdgcn_global_load_lds((const unsigned*)((gbase) + (size_t)(kt) * (BK * 2) + (voff)[_i]), (LAS unsigned*)(lds + (bufoff) + ldsw + _i * 8192), 16, 0, 0); } while (0)
#define G_LDA(dst, b, h) do { _Pragma("unroll") for (int m = 0; m < 4; ++m) _Pragma("unroll") for (int k = 0; k < 2; ++k) dst[m][k] = *(const LAS bf16x8*)(lds + G_SA(b, h) + aoff + m * 2048 + k * 1024); } while (0)
#define G_LDB(dst, b, h) do { _Pragma("unroll") for (int n = 0; n < 2; ++n) _Pragma("unroll") for (int k = 0; k < 2; ++k) dst[n][k] = *(const LAS bf16x8*)(lds + G_SB(b, h) + boff + n * 2048 + k * 1024); } while (0)
#define G_MMA(ai, bj, At, Bt) do { __builtin_amdgcn_s_setprio(1); _Pragma("unroll") for (int m = 0; m < 4; ++m) _Pragma("unroll") for (int n = 0; n < 2; ++n) _Pragma("unroll") for (int k = 0; k < 2; ++k) \
    acc[ai][bj][m][n] = __builtin_amdgcn_mfma_f32_16x16x32_bf16(Bt[n][k], At[m][k], acc[ai][bj][m][n], 0, 0, 0); __builtin_amdgcn_s_setprio(0); } while (0)
#define WAIT_V(n) asm volatile("s_waitcnt vmcnt(" #n ")" ::: "memory")
#define WAIT_L(n) asm volatile("s_waitcnt lgkmcnt(" #n ")" ::: "memory")
#define BAR __builtin_amdgcn_s_barrier()
#define SCHED __builtin_amdgcn_sched_barrier(0)
#define G_PROLOGUE() do { G_STAGE(G_SB(0, 0), gB0, voffB, 0); G_STAGE(G_SA(0, 0), gA0, voffA, 0); G_STAGE(G_SB(0, 1), gB1, voffB, 0); G_STAGE(G_SA(0, 1), gA1, voffA, 0); \
    G_STAGE(G_SB(1, 0), gB0, voffB, 1); G_STAGE(G_SA(1, 0), gA0, voffA, 1); G_STAGE(G_SB(1, 1), gB1, voffB, 1); } while (0)
  G_SETUP(u);
  asm volatile("s_waitcnt vmcnt(0) lgkmcnt(0)" ::: "memory");
  __syncthreads();
  G_PROLOGUE();
  for (int ui = 0; have; ++ui) {
    const int nt = u.K / BK;
    G_SETUP(u);
    Acc acc;
#pragma unroll
    for (int a = 0; a < 2; ++a)
#pragma unroll
      for (int b = 0; b < 2; ++b)
#pragma unroll
        for (int m = 0; m < 4; ++m)
#pragma unroll
          for (int n = 0; n < 2; ++n) acc[a][b][m][n] = (f32x4){0.f, 0.f, 0.f, 0.f};
    bf16x8 At[4][2], B0[2][2], B1[2][2];
    asm volatile("s_waitcnt vmcnt(0) lgkmcnt(0)" ::: "memory");
    __syncthreads();
    if (wr == 1) BAR;
  for (int t = 0; t < nt - 2; t += 2) {
      G_LDB(B0, 0, 0); SCHED; G_LDA(At, 0, 0); G_STAGE(G_SA(1, 1), gA1, voffA, t + 1);
      WAIT_L(8); BAR; WAIT_L(0); G_MMA(0, 0, At, B0); BAR; SCHED;
      G_LDB(B1, 0, 1); G_STAGE(G_SB(0, 0), gB0, voffB, t + 2);
      BAR; WAIT_L(0); G_MMA(0, 1, At, B1); BAR;
      G_LDA(At, 0, 1); G_STAGE(G_SA(0, 0), gA0, voffA, t + 2);
      BAR; WAIT_L(0); G_MMA(1, 0, At, B0); BAR; SCHED;
      G_STAGE(G_SB(0, 1), gB1, voffB, t + 2);
      WAIT_V(6); BAR; G_MMA(1, 1, At, B1); BAR;
      G_LDB(B0, 1, 0); SCHED; G_LDA(At, 1, 0); G_STAGE(G_SA(0, 1), gA1, voffA, t + 2);
      WAIT_L(8); BAR; WAIT_L(0); G_MMA(0, 0, At, B0); BAR; SCHED;
      G_LDB(B1, 1, 1); G_STAGE(G_SB(1, 0), gB0, voffB, t + 3);
      BAR; WAIT_L(0); G_MMA(0, 1, At, B1); BAR;
      G_LDA(At, 1, 1); G_STAGE(G_SA(1, 0), gA0, voffA, t + 3);
      BAR; WAIT_L(0); G_MMA(1, 0, At, B0); BAR; SCHED;
      G_STAGE(G_SB(1, 1), gB1, voffB, t + 3);
      WAIT_V(6); BAR; G_MMA(1, 1, At, B1); BAR;
    }
    { G_LDB(B0, 0, 0); G_LDA(At, 0, 0); G_STAGE(G_SA(1, 1), gA1, voffA, nt - 1);
      BAR; WAIT_L(0); G_MMA(0, 0, At, B0); BAR;
      G_LDB(B1, 0, 1); BAR; WAIT_L(0); G_MMA(0, 1, At, B1); BAR;
      G_LDA(At, 0, 1); WAIT_V(4); BAR; WAIT_L(0); G_MMA(1, 0, At, B0); G_MMA(1, 1, At, B1); BAR; }
    { G_LDB(B0, 1, 0); G_LDA(At, 1, 0); WAIT_V(2); BAR; WAIT_L(0); G_MMA(0, 0, At, B0); BAR;
      G_LDB(B1, 1, 1); WAIT_V(0); BAR; WAIT_L(0); G_MMA(0, 1, At, B1); BAR;
      G_LDA(At, 1, 1); BAR; WAIT_L(0); G_MMA(1, 0, At, B0); G_MMA(1, 1, At, B1); BAR; }
    if (wr == 0) BAR;
    asm volatile("" ::: "memory"); SCHED;
    const bool hn = get_unit(p, PH, blockIdx.x, ui + 1, nx);
    if (hn) { G_SETUP(nx); G_PROLOGUE(); }
    asm volatile("" ::: "memory"); SCHED;
    { int te = opaque_tid(wid_k);
      const int ewid = te >> 6, elane = te & 63, ewr = ewid >> 2, ewc = ewid & 3, efr = elane & 15, efq = elane >> 4;
      if (PH == 1) epilogue<E_G1>(p, u, acc, lds, te, ewr, ewc, efr, efq);
      else if (PH == 2) epilogue<E_DFT>(p, u, acc, lds, te, ewr, ewc, efr, efq);
      else if (PH == 3) { if (u.epi == E_Q) epilogue<E_Q>(p, u, acc, lds, te, ewr, ewc, efr, efq); else epilogue<E_KV>(p, u, acc, lds, te, ewr, ewc, efr, efq); }
      else if (PH == 4) epilogue<E_OUT>(p, u, acc, lds, te, ewr, ewc, efr, efq);
      else if (PH == 5) epilogue<E_GU>(p, u, acc, lds, te, ewr, ewc, efr, efq);
      else epilogue<E_DOWN>(p, u, acc, lds, te, ewr, ewc, efr, efq); }
    u = nx; have = hn;
  }
  asm volatile("s_waitcnt vmcnt(0) lgkmcnt(0)" ::: "memory");
  __syncthreads();
}

constexpr int SHM_V = 64 * 128 * 2, SHM_K = 64 * 192 * 2;
#define KSWZ(row, colB) ((row) * 384 + ((colB) ^ ((((row) >> 1) & 7) << 4)))
#define SBAR() __builtin_amdgcn_sched_barrier(0)
constexpr float THR = 8.0f;
__device__ __forceinline__ int crow(int r, int hi) { return (r & 3) + 8 * (r >> 2) + 4 * hi; }
__device__ __forceinline__ void partialSM(f32x16& p0, f32x16& p1, float& m_reg, float& mn, float& alpha) {
  float pmax = p0[0];
#pragma unroll
  for (int r = 1; r < 16; ++r) pmax = fmaxf(pmax, p0[r]);
#pragma unroll
  for (int r = 0; r < 16; ++r) pmax = fmaxf(pmax, p1[r]);
  { auto rr = __builtin_amdgcn_permlane32_swap(__float_as_uint(pmax), __float_as_uint(pmax), false, false); pmax = fmaxf(__uint_as_float(rr[0]), __uint_as_float(rr[1])); }
  if (__builtin_expect(__all(pmax - m_reg <= THR), 1)) { mn = m_reg; alpha = 1.f; }
  else { mn = fmaxf(m_reg, pmax); alpha = __builtin_amdgcn_exp2f(m_reg - mn); m_reg = mn; }
#pragma unroll
  for (int r = 0; r < 16; ++r) p0[r] = p0[r] - mn;
#pragma unroll
  for (int r = 0; r < 16; ++r) p1[r] = p1[r] - mn;
#pragma unroll
  for (int r = 0; r < 16; ++r) p0[r] = __builtin_amdgcn_exp2f(p0[r]);
}
__device__ __forceinline__ void finishSM(f32x16& p0, f32x16& p1, float alpha, float& l_reg, bf16x8& pa0, bf16x8& pa1, bf16x8& pa2, bf16x8& pa3) {
#pragma unroll
  for (int r = 0; r < 16; ++r) p1[r] = __builtin_amdgcn_exp2f(p1[r]);
  float ps = 0;
#pragma unroll
  for (int r = 0; r < 16; ++r) ps += p0[r];
#pragma unroll
  for (int r = 0; r < 16; ++r) ps += p1[r];
  { auto rr = __builtin_amdgcn_permlane32_swap(__float_as_uint(ps), __float_as_uint(ps), false, false); ps = __uint_as_float(rr[0]) + __uint_as_float(rr[1]); }
  l_reg = l_reg * alpha + ps;
#define PK4(P, BASE, OUT) do { unsigned a0 = cvt_pk_bf16(P[BASE + 0], P[BASE + 1]), a1 = cvt_pk_bf16(P[BASE + 2], P[BASE + 3]);   \
    unsigned b0 = cvt_pk_bf16(P[BASE + 4], P[BASE + 5]), b1 = cvt_pk_bf16(P[BASE + 6], P[BASE + 7]);                              \
    auto r0 = __builtin_amdgcn_permlane32_swap(a0, b0, false, false); auto r1 = __builtin_amdgcn_permlane32_swap(a1, b1, false, false); \
    u32x4 w = {r0[0], r1[0], r0[1], r1[1]}; OUT = *reinterpret_cast<bf16x8*>(&w); } while (0)
  PK4(p0, 0, pa0); PK4(p0, 8, pa1); PK4(p1, 0, pa2); PK4(p1, 8, pa3);
#undef PK4
}
__device__ __forceinline__ int v_st(int k, int c) { const int kk = (k & ~0xC) | ((k & 4) << 1) | ((k & 8) >> 1); return ((kk >> 3) * 4 + (c >> 5)) * 512 + ((kk & 7) * 32 + (c & 31)) * 2; }
__device__ __forceinline__ int v_rd_base(int lane) { return ((lane & 3) << 3) | (((lane >> 2) & 3) << 6) | (((lane >> 4) & 1) << 5) | (((lane >> 5) & 1) << 8); }
constexpr int v_rd_off(int d0, int ks, int half) { return d0 * 512 + ks * 4096 + half * 2048; }
struct VF { s16x4 l0, h0, l1, h1, l2, h2, l3, h3; };
#define TRR(off) __builtin_amdgcn_ds_read_tr16_b64_v4i16((LAS s16x4*)(vb + (off)))
template <int D0> __device__ __forceinline__ void load_vf(VF& f, LAS char* vb) {
  f.l0 = TRR(v_rd_off(D0, 0, 0)); f.h0 = TRR(v_rd_off(D0, 0, 1)); f.l1 = TRR(v_rd_off(D0, 1, 0)); f.h1 = TRR(v_rd_off(D0, 1, 1));
  f.l2 = TRR(v_rd_off(D0, 2, 0)); f.h2 = TRR(v_rd_off(D0, 2, 1)); f.l3 = TRR(v_rd_off(D0, 3, 0)); f.h3 = TRR(v_rd_off(D0, 3, 1));
}
#undef TRR
__device__ __forceinline__ void mma_vf(f32x16& od, const VF& f, bf16x8 pa0, bf16x8 pa1, bf16x8 pa2, bf16x8 pa3) {
#define PK(L, H) (bf16x8){L[0], L[1], L[2], L[3], H[0], H[1], H[2], H[3]}
  od = __builtin_amdgcn_mfma_f32_32x32x16_bf16(pa0, PK(f.l0, f.h0), od, 0, 0, 0);
  od = __builtin_amdgcn_mfma_f32_32x32x16_bf16(pa1, PK(f.l1, f.h1), od, 0, 0, 0);
  od = __builtin_amdgcn_mfma_f32_32x32x16_bf16(pa2, PK(f.l2, f.h2), od, 0, 0, 0);
  od = __builtin_amdgcn_mfma_f32_32x32x16_bf16(pa3, PK(f.l3, f.h3), od, 0, 0, 0);
#undef PK
}

__device__ __forceinline__ void attn_unit(const bf16_t* __restrict__ Qb, const bf16_t* __restrict__ Knb, const bf16_t* __restrict__ Krb, const bf16_t* __restrict__ Vb,
                                          bf16_t* __restrict__ Ob, int seq, LAS char* lds, int wid_k) {
  const int tid = opaque_tid(wid_k), wid = __builtin_amdgcn_readfirstlane(tid >> 6), lane = tid & 63, r32 = lane & 31, hi = lane >> 5, grp = wid >> 2;
  LAS char* V_lds = lds; LAS char* K_lds = lds + 3 * SHM_V;
  LAS float* wsl = (LAS float*)(lds + 3 * SHM_V + 2 * SHM_K) + wid * 64; LAS float* li_l = wsl; LAS float* al_l = wsl + 32;
  float m_reg = -1e30f, l_reg = 0; f32x16 o[4] = {}; bf16x8 qr[8];
  const bf16_t* Qw = Qb + (size_t)(wid * 32 + r32) * 1152 + hi * 8;
#pragma unroll
  for (int d0 = 0; d0 < 8; ++d0) qr[d0] = *(const bf16x8*)(Qw + d0 * 16);
  LAS char* qrl = lds + 3 * SHM_V + 2 * SHM_K + 2048 + wid * 4096 + r32 * 128; const int qsw = (r32 >> 1) & 7;
  const int sr = tid >> 4, sc = (tid & 15) * 8, vst0 = v_st(sr, sc);
  const int kst0 = KSWZ(sr, sc * 2), rr = tid >> 3, rc = (tid & 7) * 8, kst2 = KSWZ(rr, 256 + rc * 2);
  const unsigned goff0 = sr * 768 + sc, goff2 = rr * 64 + rc;
  const int vrb_abs = (int)(uintptr_t)V_lds + v_rd_base(lane);
  int kx[4], qx[4];
#pragma unroll
  for (int q = 0; q < 4; ++q) { kx[q] = (int)(uintptr_t)K_lds + r32 * 384 + ((q * 32 + hi * 16) ^ (((r32 >> 1) & 7) << 4)); qx[q] = (int)(uintptr_t)qrl + (((q * 2 + hi) ^ qsw) << 4); }
  int vpv = 0, vw = (1 + grp) * SHM_V;
#define LP(x) ((LAS char*)(size_t)(unsigned)(x))
  bf16x8 vs0, vs1, ks0, ks1, ks2;
#define SLOAD(t) do { const size_t k0_ = (size_t)(t) * 64; const bf16_t* vp = Vb + k0_ * 768; const bf16_t* kp = Knb + k0_ * 768; const bf16_t* rp = Krb + k0_ * 64; \
    vs0 = *(const bf16x8*)(vp + goff0); vs1 = *(const bf16x8*)(vp + goff0 + 32 * 768); ks0 = *(const bf16x8*)(kp + goff0); ks1 = *(const bf16x8*)(kp + goff0 + 32 * 768); ks2 = *(const bf16x8*)(rp + goff2); } while (0)
#define SWRITE(t, voff) do { LAS char* vd = V_lds + (voff); LAS char* kd = K_lds + ((t) & 1) * SHM_K; \
    *(LAS bf16x8*)(vd + vst0) = vs0; *(LAS bf16x8*)(vd + vst0 + 8192) = vs1; \
    *(LAS bf16x8*)(kd + kst0) = ks0; *(LAS bf16x8*)(kd + kst0 + 12288) = ks1; *(LAS bf16x8*)(kd + kst2) = ks2; } while (0)
#define SWAIT() asm volatile("s_waitcnt vmcnt(0)" ::: "memory")
#define LBAR() do { asm volatile("s_waitcnt lgkmcnt(0)" ::: "memory"); SBAR(); __builtin_amdgcn_s_barrier(); SBAR(); } while (0)
#define RESC(a) do { if (__any((a) < 1.f)) { if (hi == 0) al_l[r32] = (a); asm volatile("s_waitcnt lgkmcnt(0)" ::: "memory"); \
    _Pragma("unroll") for (int d = 0; d < 4; ++d) _Pragma("unroll") for (int r = 0; r < 16; ++r) o[d][r] *= al_l[crow(r, hi)]; } } while (0)
  f32x16 p0, p1; float mn, al; bf16x8 pa0, pa1, pa2, pa3; const int NT = seq / 64, ahead = 1 + grp;
  __syncthreads();
  { bf16x8 t0 = *(const bf16x8*)(Qw + 128), t1 = *(const bf16x8*)(Qw + 144), t2 = *(const bf16x8*)(Qw + 160), t3 = *(const bf16x8*)(Qw + 176);
    *(LAS bf16x8*)(qrl + (((0 + hi) ^ qsw) << 4)) = t0; *(LAS bf16x8*)(qrl + (((2 + hi) ^ qsw) << 4)) = t1;
    *(LAS bf16x8*)(qrl + (((4 + hi) ^ qsw) << 4)) = t2; *(LAS bf16x8*)(qrl + (((6 + hi) ^ qsw) << 4)) = t3; }
  SLOAD(0); SWAIT(); SWRITE(0, 0);
  SLOAD(1);
  LBAR();
  if (grp == 1) { SWAIT(); SWRITE(1, SHM_V); SLOAD(2); LBAR(); }
  for (int j = 0; j < NT; ++j) {
    __builtin_amdgcn_s_setprio(1);
    {
      const int kbo = (j & 1) * SHM_K;
      int ka0 = kx[0] + kbo, ka1 = kx[1] + kbo, ka2 = kx[2] + kbo, ka3 = kx[3] + kbo;
      asm volatile("" : "+v"(ka0), "+v"(ka1), "+v"(ka2), "+v"(ka3));
      bf16x8 kb0[3], kb1[3], qf[3];
#define KA(q) ((q) == 0 ? ka0 : (q) == 1 ? ka1 : (q) == 2 ? ka2 : ka3)
#define KLOAD(d0) do { LAS const char* kp_ = LP(KA((d0) & 3)) + ((d0) >> 2) * 128; kb0[(d0) % 3] = *(LAS const bf16x8*)kp_; kb1[(d0) % 3] = *(LAS const bf16x8*)(kp_ + 32 * 384); \
        if ((d0) >= 8) qf[(d0) % 3] = *(LAS const bf16x8*)LP(qx[(d0) - 8]); } while (0)
      if (j > 0) {
        int va_ = vrb_abs + vpv; asm volatile("" : "+v"(va_)); LAS char* vb = LP(va_);
        vpv = (vpv == 2 * SHM_V) ? 0 : vpv + SHM_V;
        VF va, vbf;
        load_vf<0>(va, vb); load_vf<1>(vbf, vb); SBAR();
        mma_vf(o[0], va, pa0, pa1, pa2, pa3); load_vf<2>(va, vb); SBAR();
        mma_vf(o[1], vbf, pa0, pa1, pa2, pa3); load_vf<3>(vbf, vb); SBAR();
        KLOAD(0); KLOAD(1);
        mma_vf(o[2], va, pa0, pa1, pa2, pa3); SBAR();
        mma_vf(o[3], vbf, pa0, pa1, pa2, pa3); SBAR();
      } else { KLOAD(0); KLOAD(1); SBAR(); }
      const f32x16 zero16 = {};
#pragma unroll
      for (int d0 = 0; d0 < 12; ++d0) {
        if (d0 + 2 < 12) KLOAD(d0 + 2);
        const bf16x8 qv = d0 < 8 ? qr[d0 & 7] : qf[d0 % 3];
        p0 = __builtin_amdgcn_mfma_f32_32x32x16_bf16(kb0[d0 % 3], qv, d0 == 0 ? zero16 : p0, 0, 0, 0);
        p1 = __builtin_amdgcn_mfma_f32_32x32x16_bf16(kb1[d0 % 3], qv, d0 == 0 ? zero16 : p1, 0, 0, 0);
        SBAR();
      }
#undef KLOAD
#undef KA
    }
    __builtin_amdgcn_s_setprio(0);
    LBAR();
    partialSM(p0, p1, m_reg, mn, al);
    RESC(al);
    finishSM(p0, p1, al, l_reg, pa0, pa1, pa2, pa3);
    { const int tw = j + ahead; if (tw < NT) { SWAIT(); SWRITE(tw, vw); if (tw + 1 < NT) SLOAD(tw + 1); } vw = (vw == 2 * SHM_V) ? 0 : vw + SHM_V; }
    LBAR();
  }
  { int va_ = vrb_abs + vpv; asm volatile("" : "+v"(va_)); LAS char* vb = LP(va_); VF va, vbf;
    load_vf<0>(va, vb); load_vf<1>(vbf, vb); SBAR();
    mma_vf(o[0], va, pa0, pa1, pa2, pa3); load_vf<2>(va, vb); SBAR();
    mma_vf(o[1], vbf, pa0, pa1, pa2, pa3); load_vf<3>(vbf, vb); SBAR();
    mma_vf(o[2], va, pa0, pa1, pa2, pa3); mma_vf(o[3], vbf, pa0, pa1, pa2, pa3); }
  if (grp == 0) LBAR();
  if (hi == 0) li_l[r32] = l_reg; asm volatile("s_waitcnt lgkmcnt(0)" ::: "memory");
  bf16_t* Ow = Ob + (size_t)(wid * 32) * 1024;
  float rli[16];
#pragma unroll
  for (int r = 0; r < 16; ++r) rli[r] = __builtin_amdgcn_rcpf(li_l[crow(r, hi)]);
  LAS char* ot = lds + 3 * SHM_V + 2 * SHM_K + 2048 + wid * 4096;
#pragma unroll
  for (int d0 = 0; d0 < 4; ++d0) {
#pragma unroll
    for (int r = 0; r < 16; ++r) *(LAS bf16_t*)(ot + crow(r, hi) * 80 + r32 * 2) = f2bf(o[d0][r] * rli[r]);
    asm volatile("s_waitcnt lgkmcnt(0)" ::: "memory");
    u32x4 v0 = *(LAS u32x4*)(ot + (lane >> 2) * 80 + (lane & 3) * 16), v1 = *(LAS u32x4*)(ot + (16 + (lane >> 2)) * 80 + (lane & 3) * 16);
    asm volatile("s_waitcnt lgkmcnt(0)" ::: "memory");
    *(u32x4*)(Ow + (size_t)(lane >> 2) * 1024 + d0 * 32 + (lane & 3) * 8) = v0;
    *(u32x4*)(Ow + (size_t)(16 + (lane >> 2)) * 1024 + d0 * 32 + (lane & 3) * 8) = v1;
  }
#undef SLOAD
#undef SWRITE
#undef SWAIT
#undef RESC
#undef LBAR
#undef LP
}

__device__ __forceinline__ void attn_phase(const Params& p, LAS char* lds, int wid_k) {
  char* ws = p.ws; const int c = blockIdx.x, xcd = c & 7, l = c >> 3;
  const bf16_t* Q = (const bf16_t*)(ws + OFF_Q); const bf16_t* Kn = (const bf16_t*)(ws + OFF_KN); const bf16_t* Kr = (const bf16_t*)(ws + OFF_KR); const bf16_t* V = (const bf16_t*)(ws + OFF_V);
  bf16_t* cat = (bf16_t*)(ws + OFF_XN);
  for (int i = 0; i < 9; ++i) {
    int b, h, t0, seq, tq;
    if (i < 3) { const int bh = i * 8 + xcd; b = bh / 6; h = bh % 6; seq = SP; t0 = b * SP; tq = t0 + l * 256; }
    else { const int bh = ((i - 3) * 8 + xcd) * 4 + (l >> 3); b = bh / 6; h = bh % 6; seq = SS; t0 = TP + b * SS; tq = t0 + (l & 7) * 256; }
    attn_unit(Q + (size_t)tq * 1152 + h * 192, Kn + (size_t)t0 * 768 + h * 128, Kr + (size_t)t0 * 64, V + (size_t)t0 * 768 + h * 128, cat + (size_t)tq * 1024 + 256 + h * 128, seq, lds, wid_k);
  }
}

constexpr int SHM_BYTES = 136 * 1024;

__global__ void __launch_bounds__(512) fwd_megakernel(Params p) {
  extern __shared__ __attribute__((aligned(16))) char shm_[];
  LAS char* lds = (LAS char*)shm_;
  cg::grid_group grid = cg::this_grid();
  const int wid_k = __builtin_amdgcn_readfirstlane((int)threadIdx.x >> 6);
  volatile LAS unsigned* xst = (volatile LAS unsigned*)(lds + SHM_BYTES - 16);
  if (opaque_tid(wid_k) == 0) { xst[0] = 0u; xst[1] = 0u; }
  __syncthreads();
  XcdBarrier xb = xcd_barrier_post((unsigned*)(p.ws + OFF_BAR), xst, wid_k);
  phaseA(p, lds, wid_k);
  if (p.ws == nullptr) grid.sync();
  xcd_barrier(xb, wid_k);
#ifndef NO_P1
  gemm_phase<1>(p, lds, wid_k);
  { const int l_ = blockIdx.x >> 3; if (l_ >= 16) { const int bk_ = (blockIdx.x & 7) * 16 + (l_ - 16); dft_gen(p, bk_, 128, wid_k); wprep(p, lds, 3, 4, bk_, 128, wid_k); wprep(p, lds, 5, 6, bk_, 128, wid_k); } }
#endif
  xcd_barrier(xb, wid_k);
#ifndef NO_P2
  dft_fold(p, wid_k);
  xcd_barrier(xb, wid_k);
  gemm_phase<2>(p, lds, wid_k);
  { const int l_ = blockIdx.x >> 3; if (l_ >= 17) wprep(p, lds, 4, 5, (blockIdx.x & 7) * 15 + (l_ - 17), 120, wid_k); }
#endif
  xcd_barrier(xb, wid_k);
#ifndef NO_P3
  dft_combine(p, wid_k);
  gemm_phase<3>(p, lds, wid_k);
#endif
  xcd_barrier(xb, wid_k);
#ifndef NO_ATTN
  attn_phase(p, lds, wid_k);
#endif
  xcd_barrier(xb, wid_k);
#ifndef NO_P4
  gemm_phase<4>(p, lds, wid_k);
#endif
  xcd_barrier(xb, wid_k);
#ifndef NO_P5
  gemm_phase<5>(p, lds, wid_k);
#endif
  xcd_barrier(xb, wid_k);
#ifndef NO_P6
  gemm_phase<6>(p, lds, wid_k);
#endif
}

extern "C" void kernel_launch(void* const* d_in, const int* in_sizes, int n_in, void* d_out, int out_size, void* d_ws, size_t ws_size, hipStream_t stream) {
  if (n_in != 14 || ws_size < WS_NEED || out_size != T * DM) { fprintf(stderr, "kernel_launch: unexpected shapes (n_in %d, ws %zu, out %d)\n", n_in, ws_size, out_size); return; }
  static int grid_blocks = 0;
  if (!grid_blocks) {
    hipFuncSetAttribute((const void*)fwd_megakernel, hipFuncAttributeMaxDynamicSharedMemorySize, SHM_BYTES);
    int dev = 0, cus = 0, per_cu = 0;
    hipGetDevice(&dev);
    hipDeviceGetAttribute(&cus, hipDeviceAttributeMultiprocessorCount, dev);
    hipOccupancyMaxActiveBlocksPerMultiprocessor(&per_cu, fwd_megakernel, 512, SHM_BYTES);
    if (per_cu < 1) { fprintf(stderr, "kernel_launch: occupancy 0\n"); return; }
    grid_blocks = cus < 256 ? cus : 256;
    if (grid_blocks != 256) fprintf(stderr, "kernel_launch: warning: %d CUs\n", cus);
  }
  Params p{};
  p.x_prompt = (const float*)d_in[0]; p.x_sample = (const float*)d_in[1]; p.norm_mix_g = (const float*)d_in[2]; p.w_in = (const float*)d_in[3];
  p.q_norm_g = (const float*)d_in[4]; p.w_q_up = (const float*)d_in[5]; p.kv_norm_g = (const float*)d_in[6]; p.w_kv_up = (const float*)d_in[7];
  p.w_out = (const float*)d_in[8]; p.norm_ffn_g = (const float*)d_in[9]; p.w_gate = (const float*)d_in[10]; p.w_up = (const float*)d_in[11];
  p.w_down = (const float*)d_in[12]; p.final_g = (const float*)d_in[13];
  p.out = (float*)d_out; p.ws = (char*)d_ws;
  (void)hipMemsetAsync((char*)d_ws + OFF_BAR, 0, 16384 + 384 * 64, stream);
  void* args[] = {&p};
  hipError_t e = hipLaunchCooperativeKernel((void*)fwd_megakernel, dim3(grid_blocks), dim3(512), args, SHM_BYTES, stream);
  if (e != hipSuccess) fprintf(stderr, "cooperative launch failed: %s (grid %d)\n", hipGetErrorString(e), grid_blocks);
}
```

```cpp
#include <hip/hip_runtime.h>
#include <hip/hip_cooperative_groups.h>
#include <cstdio>
#include <cstdint>
namespace cg = cooperative_groups;

#define LAS __attribute__((address_space(3)))
typedef unsigned short bf16_t;
typedef short bf16x8 __attribute__((ext_vector_type(8)));
typedef short s16x4 __attribute__((ext_vector_type(4)));
typedef float f32x4 __attribute__((ext_vector_type(4)));
typedef float f32x2 __attribute__((ext_vector_type(2)));
typedef float f32x16 __attribute__((ext_vector_type(16)));
typedef unsigned u32x4 __attribute__((ext_vector_type(4)));
typedef unsigned u32x2 __attribute__((ext_vector_type(2)));

constexpr int T = 98304, TP = 32768, SP = 8192, SS = 2048, DM = 1024, DFF = 2816;
constexpr float EPS = 1e-6f;
constexpr int KP = SP / 2 + 128, KS = SS / 2 + 128;
constexpr size_t MiB = 1u << 20;
constexpr size_t OFF_WIN = 0;
constexpr size_t OFF_WQ = OFF_WIN + 1280 * 1024 * 2;
constexpr size_t OFF_WKV = OFF_WQ + 1280 * 384 * 2;
constexpr size_t OFF_WOUT = OFF_WKV + 1536 * 256 * 2;
constexpr size_t OFF_WGU = OFF_WOUT + 1024 * 1024 * 2;
constexpr size_t OFF_WD = OFF_WGU + 5632 * 1024 * 2;
constexpr size_t OFF_ROPE = OFF_WD + 1024 * 2816 * 2;
constexpr size_t OFF_CQSSQ = OFF_ROPE + 8192 * 32 * 8;
constexpr size_t OFF_SSQ1 = OFF_CQSSQ + (size_t)T * 2 * 4;
constexpr size_t OFF_SSQ2 = OFF_SSQ1 + (size_t)T * 4 * 4;
constexpr size_t OFF_WEND = OFF_SSQ2 + (size_t)T * 4 * 4;
static_assert(OFF_WEND <= 32 * MiB, "weights region");
constexpr size_t OFF_XN = 32 * MiB;
constexpr size_t OFF_CQ = 224 * MiB;
constexpr size_t OFF_CKV = 296 * MiB;
constexpr size_t OFF_KR = 344 * MiB;
constexpr size_t OFF_DFTP = 356 * MiB;
constexpr size_t OFF_DFTS = 612 * MiB;
constexpr size_t OFF_UTFP = OFF_XN;
constexpr size_t OFF_UTFS = OFF_XN + 20 * MiB;
constexpr size_t OFF_PQP = 860 * MiB;
constexpr size_t OFF_PQS = 880 * MiB;
constexpr size_t OFF_UTP = 628 * MiB;
constexpr size_t OFF_UTS = 660 * MiB;
constexpr size_t OFF_Q = 356 * MiB;
constexpr size_t OFF_KN = 572 * MiB;
constexpr size_t OFF_V = 716 * MiB;
constexpr size_t OFF_X1B = 224 * MiB;
constexpr size_t OFF_H = 416 * MiB;
constexpr size_t OFF_BAR = 31 * MiB;
constexpr size_t OFF_CNT = OFF_BAR + 16384;
constexpr size_t WS_NEED = 944 * MiB;

struct Params {
  const float *x_prompt, *x_sample, *norm_mix_g, *w_in, *q_norm_g, *w_q_up, *kv_norm_g, *w_kv_up, *w_out, *norm_ffn_g, *w_gate, *w_up, *w_down, *final_g;
  float* out; char* ws;
};

typedef __bf16 bf16x2_t __attribute__((ext_vector_type(2)));
__device__ __forceinline__ unsigned cvt_pk_bf16(float lo, float hi) { const f32x2 v = {lo, hi}; return __builtin_bit_cast(unsigned, __builtin_convertvector(v, bf16x2_t)); }
__device__ __forceinline__ bf16_t f2bf(float x) { return (bf16_t)(cvt_pk_bf16(x, x) & 0xffffu); }
__device__ __forceinline__ u32x2 pack4(f32x4 v) { u32x2 w; w.x = cvt_pk_bf16(v[0], v[1]); w.y = cvt_pk_bf16(v[2], v[3]); return w; }
__device__ __forceinline__ int opaque_tid(int wid_k) { int l; asm volatile("v_mbcnt_lo_u32_b32 %0, -1, 0\n\tv_mbcnt_hi_u32_b32 %0, -1, %0" : "=v"(l)); return wid_k * 64 + l; }
__device__ __forceinline__ const float* xrow(const Params& p, int t) { return t < TP ? p.x_prompt + (size_t)t * DM : p.x_sample + (size_t)(t - TP) * DM; }


#define XB_TMO      128
#define XB_XCNT(j)  (256  + 64 * (j))
#define XB_XSUB(j)  (1280 + 64 * (j))
#define XB_XGEN(j)  (2304 + 64 * (j))
#define XB_TOP      3328
#define XB_TOPGEN   3392
#define XCD_BAR_WORDS 3456
#define XB_SPIN_CAP (1u << 18)
__device__ __forceinline__ unsigned xb_ld(unsigned* p)              { return __hip_atomic_load(p, __ATOMIC_RELAXED, __HIP_MEMORY_SCOPE_AGENT); }
__device__ __forceinline__ unsigned xb_add(unsigned* p, unsigned v) { return __hip_atomic_fetch_add(p, v, __ATOMIC_RELAXED, __HIP_MEMORY_SCOPE_AGENT); }
__device__ __forceinline__ unsigned xb_xcc_id() { return (unsigned)__builtin_amdgcn_s_getreg((3 << 11) | 20) & 0xFu; }
#define XB_SPIN(cond, bar) do { unsigned _sp = 0; while (cond) { __builtin_amdgcn_s_sleep(1); \
    if ((++_sp & 255u) == 0u) { if (xb_ld(&(bar)[XB_TMO])) break; if (_sp > XB_SPIN_CAP) { atomicAdd(&(bar)[XB_TMO], 1u); break; } } } } while (0)
struct XcdBarrier { unsigned* bar; unsigned x; volatile LAS unsigned* st; };
__device__ __forceinline__ XcdBarrier xcd_barrier_post(unsigned* bar, volatile LAS unsigned* st, int wid_k) {
  XcdBarrier b; b.bar = bar; b.x = xb_xcc_id(); b.st = st;
  if (opaque_tid(wid_k) == 0) (void)xb_add(&bar[XB_XCNT(b.x)], 1u);
  return b;
}
__device__ __forceinline__ void xcd_barrier_complete(unsigned* bar, unsigned x, unsigned& nloc, unsigned& nx) {
  const unsigned G = gridDim.x * gridDim.y * gridDim.z;
  unsigned sum, cnt, mine, sp = 0u;
  for (;;) {
    sum = 0u; cnt = 0u; mine = 0u;
#pragma unroll
    for (unsigned j = 0; j < 16; ++j) { const unsigned c = xb_ld(&bar[XB_XCNT(j)]); sum += c; cnt += (c > 0u) ? 1u : 0u; mine = (j == x) ? c : mine; }
    if (sum == G) break;
    __builtin_amdgcn_s_sleep(1);
    if ((++sp & 255u) == 0u) { if (xb_ld(&bar[XB_TMO])) break; if (sp > XB_SPIN_CAP) { atomicAdd(&bar[XB_TMO], 1u); break; } }
  }
  nloc = mine > 0u ? mine : 1u; nx = cnt > 0u ? cnt : 1u;
}
__device__ __forceinline__ void xcd_barrier(const XcdBarrier& b, int wid_k) {
  asm volatile("s_waitcnt vmcnt(0)" ::: "memory");
  __syncthreads();
  if (opaque_tid(wid_k) == 0) {
    unsigned* bar = b.bar;
    __builtin_amdgcn_s_waitcnt(0);
    unsigned nloc = b.st[0], nx = b.st[1];
    if (nloc == 0u) { xcd_barrier_complete(bar, b.x, nloc, nx); b.st[0] = nloc; b.st[1] = nx; }
    const unsigned old = xb_add(&bar[XB_XSUB(b.x)], 1u);
    const unsigned gen = old / nloc;
    if (old + 1u == (gen + 1u) * nloc) {
      __builtin_amdgcn_fence(__ATOMIC_RELEASE, "agent");
      asm volatile("s_waitcnt vmcnt(0)" ::: "memory");
      const unsigned og = xb_add(&bar[XB_TOP], 1u);
      const unsigned tg = og / nx;
      if (og + 1u == (tg + 1u) * nx) xb_add(&bar[XB_TOPGEN], 1u);
      else XB_SPIN(xb_ld(&bar[XB_TOPGEN]) == tg, bar);
      __builtin_amdgcn_fence(__ATOMIC_ACQUIRE, "agent");
      xb_add(&bar[XB_XGEN(b.x)], 1u);
      asm volatile("s_waitcnt vmcnt(0)" ::: "memory");
    } else {
      XB_SPIN(xb_ld(&bar[XB_XGEN(b.x)]) == gen, bar);
      __builtin_amdgcn_fence(__ATOMIC_ACQUIRE, "agent");
      asm volatile("s_waitcnt vmcnt(0)" ::: "memory");
    }
  }
  __syncthreads();
}

__device__ __forceinline__ void dft_gen(const Params& p, int bk, int nbk, int wid_k) {
  const int tid = opaque_tid(wid_k); char* ws = p.ws;
#pragma unroll
  for (int part = 0; part < 2; ++part) {
    const int S = part ? SS : SP, K = part ? KS : KP, R = part ? 1280 : 4352, cpr = 2 * K / 8;
    bf16_t* d = (bf16_t*)(ws + (part ? OFF_DFTS : OFF_DFTP));
    const float sc = part ? 0.022097086912079612f : 0.011048543456039806f, inv = 1.0f / (float)S;
    for (int g = bk * 512 + tid; g < R * cpr; g += nbk * 512) {
      const int k = g / cpr, c8 = (g % cpr) * 8, half = c8 >= K ? 1 : 0, s0 = c8 - half * K;
      int idx = (k * s0) & (S - 1); float v[8];
#pragma unroll
      for (int e = 0; e < 8; ++e) { const int sp = s0 + e; const float fr = (float)idx * inv;
        const bool ok = half ? (sp >= 1 && sp <= S / 2 - 1) : (sp <= S / 2);
        v[e] = ok ? sc * (half ? __builtin_amdgcn_sinf(fr) : __builtin_amdgcn_cosf(fr)) : 0.f; idx = (idx + k) & (S - 1); }
      u32x4 w = {cvt_pk_bf16(v[0], v[1]), cvt_pk_bf16(v[2], v[3]), cvt_pk_bf16(v[4], v[5]), cvt_pk_bf16(v[6], v[7])};
      *(u32x4*)(d + (size_t)k * (2 * K) + c8) = w;
    }
  }
}

struct FoldItem { u32x4 f, c1; unsigned m0; int s0, half; bf16_t* dst; };
__device__ __forceinline__ void fold_load(FoldItem& it, const bf16_t* __restrict__ ut, bf16_t* __restrict__ uf, int g, int S, int K) {
  const int cph = K / 8, row = g / (2 * cph), rem = g % (2 * cph); it.half = rem >= cph ? 1 : 0; it.s0 = (rem - it.half * cph) * 8;
  const bf16_t* U = ut + (size_t)row * (2 * S) + it.half * S;
  it.f = *(const u32x4*)(U + it.s0); it.c1 = *(const u32x4*)(U + S - it.s0 - 8); it.m0 = U[S - it.s0];
  it.dst = uf + (size_t)row * (2 * K) + it.half * K + it.s0;
}
__device__ __forceinline__ void fold_store(const FoldItem& it, int S) {
  const int H = S / 2; float F[8], C[8], M[8], o[8];
#pragma unroll
  for (int e = 0; e < 4; ++e) { F[2 * e] = __uint_as_float(it.f[e] << 16); F[2 * e + 1] = __uint_as_float(it.f[e] & 0xffff0000u); C[2 * e] = __uint_as_float(it.c1[e] << 16); C[2 * e + 1] = __uint_as_float(it.c1[e] & 0xffff0000u); }
  M[0] = __uint_as_float(it.m0 << 16);
#pragma unroll
  for (int e = 1; e < 8; ++e) M[e] = C[8 - e];
#pragma unroll
  for (int e = 0; e < 8; ++e) { const int sp = it.s0 + e; const bool mid = sp >= 1 && sp <= H - 1;
    o[e] = it.half ? (mid ? F[e] - M[e] : 0.f) : (mid ? F[e] + M[e] : ((sp == 0 || sp == H) ? F[e] : 0.f)); }
  *(u32x4*)it.dst = (u32x4){cvt_pk_bf16(o[0], o[1]), cvt_pk_bf16(o[2], o[3]), cvt_pk_bf16(o[4], o[5]), cvt_pk_bf16(o[6], o[7])};
}
__device__ __forceinline__ void dft_fold(const Params& p, int wid_k) {
  const int tid = opaque_tid(wid_k); char* ws = p.ws;
#pragma unroll
  for (int part = 0; part < 2; ++part) {
    const int S = part ? SS : SP, K = part ? KS : KP, NR = part ? 8192 : 1024, nitem = NR * 2 * (K / 8), stride = gridDim.x * 512;
    const bf16_t* ut = (const bf16_t*)(ws + (part ? OFF_UTS : OFF_UTP)); bf16_t* uf = (bf16_t*)(ws + (part ? OFF_UTFS : OFF_UTFP));
    for (int g = blockIdx.x * 512 + tid; g < nitem; g += 2 * stride) {
      FoldItem a, b; const bool hb = g + stride < nitem;
      fold_load(a, ut, uf, g, S, K); fold_load(b, ut, uf, hb ? g + stride : g, S, K);
      fold_store(a, S); if (hb) fold_store(b, S);
    }
  }
}

__device__ __forceinline__ bool wmap(const Params& p, int mat, int j, const float*& src, int& col, int& ld, const float*& gain) {
  switch (mat) {
    case 0: {
      src = p.w_in; ld = 960; gain = p.norm_mix_g;
      if (j < 768) { col = 640 + (j - 512); return true; }
      if (j < 1152) { col = 256 + (j - 768); return true; }
      if (j < 1216) { int q = j - 1152; col = 896 + ((q >> 2) & 1) * 32 + (q >> 5) * 16 + ((q >> 3) & 3) * 4 + (q & 3); return true; }
      return false; }
    case 1: {
      src = p.w_q_up; ld = 1152; gain = p.q_norm_g;
      int g = j >> 6; if (g >= 18) return false;
      if (g % 3 == 2) { int q = j & 63; col = (g / 3) * 192 + 128 + ((q >> 2) & 1) * 32 + (q >> 5) * 16 + ((q >> 3) & 3) * 4 + (q & 3); } else col = j;
      return true; }
    case 2: src = p.w_kv_up; ld = 1536; gain = p.kv_norm_g; col = j; return true;
    case 3: src = p.w_out; ld = 1024; gain = nullptr; col = j; return true;
    case 4: { int tile = j >> 8, half = (j >> 7) & 1; src = half ? p.w_up : p.w_gate; ld = DFF; gain = p.norm_ffn_g; col = tile * 128 + (j & 127); return true; }
    default: src = p.w_down; ld = 1024; gain = nullptr; col = j; return true;
  }
}

__device__ __forceinline__ void wprep(const Params& p, LAS char* lds, int mat0, int mat1, int bid, int nb, int wid_k) {
  const int tid = opaque_tid(wid_k); char* ws = p.ws;
  __syncthreads();
  {
    LAS float* tl = (LAS float*)lds;
    const int nrows[6] = {768, 1280, 1536, 1024, 5632, 1024}, kk_[6] = {1024, 384, 256, 1024, 1024, 2816}, row0[6] = {512, 0, 0, 0, 0, 0};
    const size_t offs[6] = {OFF_WIN, OFF_WQ, OFF_WKV, OFF_WOUT, OFF_WGU, OFF_WD};
    int job = bid;
#pragma unroll
    for (int mat = 0; mat < 6; ++mat) {
      if (mat < mat0 || mat >= mat1) continue;
      const int K = kk_[mat], ntk = K / 64, ntiles = (nrows[mat] / 64) * ntk;
      bf16_t* dst = (bf16_t*)(ws + offs[mat]);
      for (; job < ntiles; job += nb) {
        const int j0 = row0[mat] + (job / ntk) * 64, k0 = (job % ntk) * 64;
        { const int kk = tid >> 3, jj0 = (tid & 7) * 8; const float* src; int col, ld; const float* gain;
          f32x4 a = {0.f, 0.f, 0.f, 0.f}, b = a;
          if (wmap(p, mat, j0 + jj0, src, col, ld, gain)) { a = *(const f32x4*)(src + (size_t)(k0 + kk) * ld + col); if (gain) a = a * gain[k0 + kk]; }
          if (wmap(p, mat, j0 + jj0 + 4, src, col, ld, gain)) { b = *(const f32x4*)(src + (size_t)(k0 + kk) * ld + col); if (gain) b = b * gain[k0 + kk]; }
#pragma unroll
          for (int e = 0; e < 4; ++e) { tl[kk * 65 + jj0 + e] = a[e]; tl[kk * 65 + jj0 + 4 + e] = b[e]; } }
        __syncthreads();
        { const int jj = tid >> 3, kk0 = (tid & 7) * 8; float v[8];
#pragma unroll
          for (int e = 0; e < 8; ++e) v[e] = tl[(kk0 + e) * 65 + jj];
          u32x4 w = {cvt_pk_bf16(v[0], v[1]), cvt_pk_bf16(v[2], v[3]), cvt_pk_bf16(v[4], v[5]), cvt_pk_bf16(v[6], v[7])};
          *(u32x4*)(dst + (size_t)(j0 + jj) * K + k0 + kk0) = w; }
        __syncthreads();
      }
      job -= ntiles;
    }
  }
}


__device__ __forceinline__ void phaseA(const Params& p, LAS char* lds, int wid_k) {
  const int tid = opaque_tid(wid_k), bid = blockIdx.x, nb = gridDim.x, wid = tid >> 6, lane = tid & 63;
  char* ws = p.ws;
  {
    bf16_t* xn = (bf16_t*)(ws + OFF_XN);
    for (int t = (bid * 8 + wid) * 4; t < T; t += nb * 32) {
      f32x4 v[4][4]; float ss[4];
#pragma unroll
      for (int r = 0; r < 4; ++r) { const float* src = xrow(p, t + r);
#pragma unroll
        for (int i = 0; i < 4; ++i) v[r][i] = *(const f32x4*)(src + i * 256 + lane * 4); }
#pragma unroll
      for (int r = 0; r < 4; ++r) { float a = 0.f;
#pragma unroll
        for (int i = 0; i < 4; ++i) a += v[r][i][0] * v[r][i][0] + v[r][i][1] * v[r][i][1] + v[r][i][2] * v[r][i][2] + v[r][i][3] * v[r][i][3];
        ss[r] = a; }
#pragma unroll
      for (int o = 32; o >= 1; o >>= 1) {
#pragma unroll
        for (int r = 0; r < 4; ++r) ss[r] += __shfl_xor(ss[r], o); }
#pragma unroll
      for (int r = 0; r < 4; ++r) { const float rs = __builtin_amdgcn_rsqf(ss[r] * (1.0f / DM) + EPS);
#pragma unroll
        for (int i = 0; i < 4; ++i) *(u32x2*)(xn + (size_t)(t + r) * DM + i * 256 + lane * 4) = pack4(v[r][i] * rs); }
    }
  }
  {
    f32x2* tab = (f32x2*)(ws + OFF_ROPE);
    for (int g = bid * 512 + tid; g < 8192 * 32; g += nb * 512) {
      const int pos = g >> 5, i = g & 31;
      double f = 0.15915494309189535;
      const double r = 0.74989420933245582;
      for (int e = 0; e < i; ++e) f *= r;
      double a = (double)pos * f; a -= __builtin_floor(a);
      const float fr = (float)a;
      tab[g] = (f32x2){__builtin_amdgcn_cosf(fr), __builtin_amdgcn_sinf(fr)};
    }
  }
  {
    LAS float* ctab = (LAS float*)lds;
    if (tid < 64) ctab[tid] = __builtin_amdgcn_cosf((float)tid * (1.0f / 64.0f));
    __syncthreads();
    bf16_t* wt = (bf16_t*)(ws + OFF_WIN);
    for (int g = bid * 512 + tid; g < 512 * 1024; g += nb * 512) {
      const int j = g >> 10, k = g & 1023, part = j >> 8, grp = (j >> 6) & 3, cp = j & 63;
      const float* src = p.w_in + (size_t)k * 960 + grp * 64; float a = 0.f;
      for (int c = 0; c < 64; c += 4) { const f32x4 w = *(const f32x4*)(src + c);
#pragma unroll
        for (int e = 0; e < 4; ++e) a += w[e] * ctab[((c + e) * cp + part * 16) & 63]; }
      wt[(size_t)j * 1024 + k] = f2bf(a * 0.125f * p.norm_mix_g[k]);
    }
    __syncthreads();
  }
  wprep(p, lds, 0, 3, bid, nb, wid_k);
}

constexpr int BK = 64, HTB = 128 * 64 * 2;
__device__ __forceinline__ int lds_byte(int r, int c) { const int st = (r >> 4) * 2 + (c >> 5), rr = r & 15, cc = c & 31, ob = rr * 64 + cc * 2; return st * 1024 + (ob ^ (((ob >> 9) & 1) << 5)); }
__device__ __forceinline__ void stage_rc(int b, int& R, int& C) { const int st = b / 1024, sb = b % 1024, swz = sb ^ (((sb >> 9) & 1) << 5); R = (st >> 1) * 16 + swz / 64; C = (st & 1) * 32 + (swz % 64) / 2; }

struct Unit { const bf16_t* A; const bf16_t* Bt; int lda, ldb, K, epi, pm, pn, aux; };
enum { E_G1 = 0, E_DFT, E_Q, E_KV, E_OUT, E_GU, E_DOWN };

typedef f32x4 Acc[2][2][4][2];

template <int BJ0, int BJ1>
__device__ __forceinline__ void row_ssq_to_lds(const Acc& acc, LAS float* P, int wr, int wc, int fr, int fq) {
#pragma unroll
  for (int ai = 0; ai < 2; ++ai)
#pragma unroll
    for (int m = 0; m < 4; ++m) {
      float s = 0.f;
#pragma unroll
      for (int bj = BJ0; bj < BJ1; ++bj)
#pragma unroll
        for (int n = 0; n < 2; ++n) { const f32x4 x = acc[ai][bj][m][n]; s += (x[0] * x[0] + x[1] * x[1]) + (x[2] * x[2] + x[3] * x[3]); }
      { auto r16 = __builtin_amdgcn_permlane16_swap(__float_as_uint(s), __float_as_uint(s), false, false); s = __uint_as_float(r16[0]) + __uint_as_float(r16[1]); }
      { auto r32 = __builtin_amdgcn_permlane32_swap(__float_as_uint(s), __float_as_uint(s), false, false); s = __uint_as_float(r32[0]) + __uint_as_float(r32[1]); }
      if (fq == 0) P[(ai * 128 + wr * 64 + m * 16 + fr) * 4 + wc] = s;
    }
}

__device__ __forceinline__ u32x4 pack8(f32x4 a, f32x4 b) { u32x4 w; w.x = cvt_pk_bf16(a[0], a[1]); w.y = cvt_pk_bf16(a[2], a[3]); w.z = cvt_pk_bf16(b[0], b[1]); w.w = cvt_pk_bf16(b[2], b[3]); return w; }
template <int EPI>
__device__ __forceinline__ void epilogue(const Params& p, const Unit& u, Acc& acc, LAS char* lds, int tid, int wr, int wc, int fr, int fq) {
  char* ws = p.ws;
  const int brow = u.pm * 256;
  LAS float* P = (LAS float*)(lds + 8 * HTB);
  const int rl0 = wr * 64 + fr;
  const int cl0 = wc * 32 + fq * 8;
  switch (EPI) {
    case E_G1: {
      const int pn = u.pn;
      if (pn < 2) {
        const bool prm = brow < TP; const int S = prm ? SP : SS, tt = prm ? brow : brow - TP, b = tt / S, s0 = tt % S;
        bf16_t* base = (bf16_t*)(ws + (prm ? OFF_UTP : OFF_UTS)) + (size_t)(b * 256) * (2 * S) + pn * S + s0;
        const size_t ldu = 2 * S;
#pragma unroll
        for (int ai = 0; ai < 2; ++ai)
#pragma unroll
          for (int m = 0; m < 4; ++m)
#pragma unroll
            for (int bj = 0; bj < 2; ++bj) *(u32x4*)(base + (size_t)(ai * 128 + rl0 + m * 16) * ldu + bj * 128 + cl0) = pack8(acc[ai][bj][m][0], acc[ai][bj][m][1]);
      } else if (pn == 2) {
        row_ssq_to_lds<0, 2>(acc, P, wr, wc, fr, fq);
        __syncthreads();
        bf16_t* o = (bf16_t*)(ws + OFF_CKV);
#pragma unroll
        for (int ai = 0; ai < 2; ++ai)
#pragma unroll
          for (int m = 0; m < 4; ++m) {
            const int rl = ai * 128 + rl0 + m * 16; const f32x4 q = *(LAS f32x4*)(P + rl * 4);
            const float rs = __builtin_amdgcn_rsqf(((q[0] + q[1]) + (q[2] + q[3])) * (1.0f / 256.0f) + EPS);
#pragma unroll
            for (int bj = 0; bj < 2; ++bj) *(u32x4*)(o + (size_t)(brow + rl) * 256 + bj * 128 + cl0) = pack8(acc[ai][bj][m][0] * rs, acc[ai][bj][m][1] * rs);
          }
      } else if (pn == 3) {
        row_ssq_to_lds<0, 2>(acc, P, wr, wc, fr, fq);
        __syncthreads();
        if (tid < 256) { const f32x4 q = *(LAS f32x4*)(P + tid * 4); ((float*)(ws + OFF_CQSSQ))[(size_t)(brow + tid) * 2 + 0] = (q[0] + q[1]) + (q[2] + q[3]); }
        bf16_t* o = (bf16_t*)(ws + OFF_CQ);
#pragma unroll
        for (int ai = 0; ai < 2; ++ai)
#pragma unroll
          for (int m = 0; m < 4; ++m)
#pragma unroll
            for (int bj = 0; bj < 2; ++bj) *(u32x4*)(o + (size_t)(brow + ai * 128 + rl0 + m * 16) * 384 + bj * 128 + cl0) = pack8(acc[ai][bj][m][0], acc[ai][bj][m][1]);
      } else {
        row_ssq_to_lds<0, 1>(acc, P, wr, wc, fr, fq);
        __syncthreads();
        if (tid < 256) { const f32x4 q = *(LAS f32x4*)(P + tid * 4); ((float*)(ws + OFF_CQSSQ))[(size_t)(brow + tid) * 2 + 1] = (q[0] + q[1]) + (q[2] + q[3]); }
        bf16_t* o = (bf16_t*)(ws + OFF_CQ);
        bf16_t* kr = (bf16_t*)(ws + OFF_KR);
        const f32x2* tab = (const f32x2*)(ws + OFF_ROPE);
        const bool prm = brow < TP; const int S = prm ? SP : SS, pos0 = (prm ? brow : brow - TP) & (S - 1);
#pragma unroll
        for (int ai = 0; ai < 2; ++ai)
#pragma unroll
          for (int m = 0; m < 4; ++m) {
            const int rl = ai * 128 + rl0 + m * 16;
            *(u32x4*)(o + (size_t)(brow + rl) * 384 + 256 + cl0) = pack8(acc[ai][0][m][0], acc[ai][0][m][1]);
            if (wc < 2) {
              const int i0 = wc * 16 + fq * 4; const f32x2* tp = tab + (size_t)(pos0 + rl) * 32 + i0;
              f32x4 lo, hi; const f32x4 x1 = acc[ai][1][m][0], x2 = acc[ai][1][m][1];
#pragma unroll
              for (int j = 0; j < 4; ++j) { const f32x2 cs = tp[j]; lo[j] = x1[j] * cs.x - x2[j] * cs.y; hi[j] = x2[j] * cs.x + x1[j] * cs.y; }
              *(u32x2*)(kr + (size_t)(brow + rl) * 64 + i0) = pack4(lo); *(u32x2*)(kr + (size_t)(brow + rl) * 64 + 32 + i0) = pack4(hi);
            }
          }
      }
    } break;
    case E_DFT: {
      bf16_t* o = (bf16_t*)(ws + (u.pm ? OFF_PQS : OFF_PQP)) + (size_t)u.pn * 256;
#pragma unroll
      for (int ai = 0; ai < 2; ++ai)
#pragma unroll
        for (int m = 0; m < 4; ++m)
#pragma unroll
          for (int bj = 0; bj < 2; ++bj) *(u32x4*)(o + (size_t)(ai * 128 + rl0 + m * 16) * 256 + bj * 128 + cl0) = pack8(acc[ai][bj][m][0], acc[ai][bj][m][1]);
    } break;
    case E_Q: {
      bf16_t* o = (bf16_t*)(ws + OFF_Q);
      const f32x2* tab = (const f32x2*)(ws + OFF_ROPE);
      const float* ssq = (const float*)(ws + OFF_CQSSQ);
      const bool prm = brow < TP; const int S = prm ? SP : SS, pos0 = (prm ? brow : brow - TP) & (S - 1);
      const float QS = 0.07216878364870322f * 1.4426950408889634f;
#pragma unroll
      for (int ai = 0; ai < 2; ++ai)
#pragma unroll
        for (int m = 0; m < 4; ++m) {
          const int rl = ai * 128 + rl0 + m * 16; const f32x2 sq = *(const f32x2*)(ssq + (size_t)(brow + rl) * 2);
          const float rs = __builtin_amdgcn_rsqf((sq.x + sq.y) * (1.0f / 384.0f) + EPS) * QS;
#pragma unroll
          for (int bj = 0; bj < 2; ++bj) {
            const int g = u.pn * 4 + bj * 2 + (wc >> 1);
            if (g >= 18) continue;
            if (g % 3 == 2) {
              const int i0 = (wc & 1) * 16 + fq * 4; const f32x2* tp = tab + (size_t)(pos0 + rl) * 32 + i0;
              f32x4 lo, hi; const f32x4 x1 = acc[ai][bj][m][0] * rs, x2 = acc[ai][bj][m][1] * rs;
#pragma unroll
              for (int j = 0; j < 4; ++j) { const f32x2 cs = tp[j]; lo[j] = x1[j] * cs.x - x2[j] * cs.y; hi[j] = x2[j] * cs.x + x1[j] * cs.y; }
              bf16_t* q = o + (size_t)(brow + rl) * 1152 + g * 64 + i0;
              *(u32x2*)q = pack4(lo); *(u32x2*)(q + 32) = pack4(hi);
            } else {
              *(u32x4*)(o + (size_t)(brow + rl) * 1152 + u.pn * 256 + bj * 128 + cl0) = pack8(acc[ai][bj][m][0] * rs, acc[ai][bj][m][1] * rs);
            }
          }
        }
    } break;
    case E_KV: {
      bf16_t* ok = (bf16_t*)(ws + OFF_KN); bf16_t* ov = (bf16_t*)(ws + OFF_V);
#pragma unroll
      for (int ai = 0; ai < 2; ++ai)
#pragma unroll
        for (int m = 0; m < 4; ++m) {
          const size_t ro = (size_t)(brow + ai * 128 + rl0 + m * 16) * 768 + u.pn * 128 + cl0;
          *(u32x4*)(ok + ro) = pack8(acc[ai][0][m][0], acc[ai][0][m][1]); *(u32x4*)(ov + ro) = pack8(acc[ai][1][m][0], acc[ai][1][m][1]);
        }
    } break;
    case E_OUT: {
      const float* xb = xrow(p, brow); bf16_t* ob = (bf16_t*)(ws + OFF_X1B) + (size_t)brow * DM;
      f32x4 ra[2][2][2], rb[2][2][2];
#define EO_LOAD(R, B) do { _Pragma("unroll") for (int m = 0; m < 2; ++m) _Pragma("unroll") for (int bj = 0; bj < 2; ++bj) _Pragma("unroll") for (int n = 0; n < 2; ++n) \
        R[m][bj][n] = *(const f32x4*)(xb + (size_t)(((B) >> 1) * 128 + rl0 + (((B) & 1) * 2 + m) * 16) * DM + u.pn * 256 + bj * 128 + cl0 + n * 4); } while (0)
#define EO_PROC(R, B) do { _Pragma("unroll") for (int m = 0; m < 2; ++m) _Pragma("unroll") for (int bj = 0; bj < 2; ++bj) { const int ai_ = (B) >> 1, mm_ = ((B) & 1) * 2 + m; \
        const size_t off = (size_t)(ai_ * 128 + rl0 + mm_ * 16) * DM + u.pn * 256 + bj * 128 + cl0; \
        const f32x4 v0 = acc[ai_][bj][mm_][0] + R[m][bj][0], v1 = acc[ai_][bj][mm_][1] + R[m][bj][1]; acc[ai_][bj][mm_][0] = v0; acc[ai_][bj][mm_][1] = v1; \
        *(u32x4*)(ob + off) = pack8(v0, v1); } } while (0)
#define EO_FENCE() do { asm volatile("" ::: "memory"); __builtin_amdgcn_sched_barrier(0); } while (0)
      EO_LOAD(ra, 0); EO_LOAD(rb, 1); EO_FENCE();
      EO_PROC(ra, 0); EO_FENCE(); EO_LOAD(ra, 2); EO_FENCE();
      EO_PROC(rb, 1); EO_FENCE(); EO_LOAD(rb, 3); EO_FENCE();
      EO_PROC(ra, 2); EO_FENCE();
      EO_PROC(rb, 3); EO_FENCE();
#undef EO_LOAD
#undef EO_PROC
      row_ssq_to_lds<0, 2>(acc, P, wr, wc, fr, fq);
      __syncthreads();
      if (tid < 256) { const f32x4 q = *(LAS f32x4*)(P + tid * 4); ((float*)(ws + OFF_SSQ1))[(size_t)(brow + tid) * 4 + u.pn] = (q[0] + q[1]) + (q[2] + q[3]); }
    } break;
    case E_GU: {
      bf16_t* o = (bf16_t*)(ws + OFF_H);
#pragma unroll
      for (int ai = 0; ai < 2; ++ai)
#pragma unroll
        for (int m = 0; m < 4; ++m) {
          const int rl = ai * 128 + rl0 + m * 16;
          const float rs = ((const LAS float*)(lds + u.aux))[rl];
          const float rsl = rs * -1.4426950408889634f; u32x4 w;
#pragma unroll
          for (int n = 0; n < 2; ++n)
#pragma unroll
            for (int jp = 0; jp < 2; ++jp) {
              const f32x2 a0 = {acc[ai][0][m][n][2 * jp], acc[ai][0][m][n][2 * jp + 1]}, a1 = {acc[ai][1][m][n][2 * jp], acc[ai][1][m][n][2 * jp + 1]};
              const f32x2 g = a0 * rs, uu = a1 * rs, e2 = a0 * rsl;
              const f32x2 d = (f32x2){__builtin_amdgcn_exp2f(e2.x), __builtin_amdgcn_exp2f(e2.y)} + 1.0f;
              const f32x2 hh = (g * uu) * (f32x2){__builtin_amdgcn_rcpf(d.x), __builtin_amdgcn_rcpf(d.y)};
              w[n * 2 + jp] = cvt_pk_bf16(hh.x, hh.y); }
          *(u32x4*)(o + (size_t)(brow + rl) * DFF + u.pn * 128 + cl0) = w;
        }
    } break;
    default: {
      float* o = p.out + (size_t)brow * DM; const bf16_t* x1b = (const bf16_t*)(ws + OFF_X1B) + (size_t)brow * DM;
      u32x4 ra[2][2], rb[2][2];
#define ED_LOAD(R, B) do { _Pragma("unroll") for (int m = 0; m < 2; ++m) _Pragma("unroll") for (int bj = 0; bj < 2; ++bj) \
        R[m][bj] = *(const u32x4*)(x1b + (size_t)(((B) >> 1) * 128 + rl0 + (((B) & 1) * 2 + m) * 16) * DM + u.pn * 256 + bj * 128 + cl0); } while (0)
#define ED_PROC(R, B) do { _Pragma("unroll") for (int m = 0; m < 2; ++m) _Pragma("unroll") for (int bj = 0; bj < 2; ++bj) { const int ai_ = (B) >> 1, mm_ = ((B) & 1) * 2 + m; const u32x4 w = R[m][bj]; \
        acc[ai_][bj][mm_][0] = acc[ai_][bj][mm_][0] + (f32x4){__uint_as_float(w.x << 16), __uint_as_float(w.x & 0xffff0000u), __uint_as_float(w.y << 16), __uint_as_float(w.y & 0xffff0000u)}; \
        acc[ai_][bj][mm_][1] = acc[ai_][bj][mm_][1] + (f32x4){__uint_as_float(w.z << 16), __uint_as_float(w.z & 0xffff0000u), __uint_as_float(w.w << 16), __uint_as_float(w.w & 0xffff0000u)}; } } while (0)
      ED_LOAD(ra, 0); ED_LOAD(rb, 1); EO_FENCE();
      ED_PROC(ra, 0); EO_FENCE(); ED_LOAD(ra, 2); EO_FENCE();
      ED_PROC(rb, 1); EO_FENCE(); ED_LOAD(rb, 3); EO_FENCE();
      ED_PROC(ra, 2); ED_PROC(rb, 3); EO_FENCE();
#undef ED_LOAD
#undef ED_PROC
      row_ssq_to_lds<0, 2>(acc, P, wr, wc, fr, fq);
      __syncthreads();
      float* ssq = (float*)(ws + OFF_SSQ2);
      unsigned* cnt = (unsigned*)(ws + OFF_CNT) + u.pm * 16;
      if (tid < 256) { const f32x4 q = *(LAS f32x4*)(P + tid * 4);
        __hip_atomic_store(ssq + (size_t)(brow + tid) * 4 + u.pn, (q[0] + q[1]) + (q[2] + q[3]), __ATOMIC_RELAXED, __HIP_MEMORY_SCOPE_AGENT);
        asm volatile("s_waitcnt vmcnt(0)" ::: "memory");
        if ((tid & 63) == 0) __hip_atomic_fetch_add(cnt, 1u, __ATOMIC_RELAXED, __HIP_MEMORY_SCOPE_AGENT); }
      if (__builtin_amdgcn_readfirstlane(tid >> 6) == 0) {
        unsigned spins = 0;
        while ((unsigned)__builtin_amdgcn_readfirstlane(__hip_atomic_load(cnt, __ATOMIC_RELAXED, __HIP_MEMORY_SCOPE_AGENT)) < 16u) { __builtin_amdgcn_s_sleep(2); if (++spins > (1u << 22)) break; }
        __builtin_amdgcn_fence(__ATOMIC_ACQUIRE, "agent");
      }
      asm volatile("s_waitcnt vmcnt(0) lgkmcnt(0)" ::: "memory");
      __syncthreads();
      asm volatile("" ::: "memory"); __builtin_amdgcn_sched_barrier(0);
      int rl0b = rl0, cl0b = cl0; asm volatile("" : "+v"(rl0b), "+v"(cl0b));
      const float* fg = p.final_g + u.pn * 256 + cl0b;
      f32x4 gv[2][2];
#pragma unroll
      for (int bj = 0; bj < 2; ++bj)
#pragma unroll
        for (int n = 0; n < 2; ++n) gv[bj][n] = *(const f32x4*)(fg + bj * 128 + n * 4);
#pragma unroll
      for (int ai = 0; ai < 2; ++ai)
#pragma unroll
        for (int m = 0; m < 4; ++m) {
          const int rl = ai * 128 + rl0b + m * 16;
          const f32x4 sq4 = *(const volatile f32x4*)(ssq + (size_t)(brow + rl) * 4);
          const float rs = __builtin_amdgcn_rsqf(((sq4[0] + sq4[1]) + (sq4[2] + sq4[3])) * (1.0f / DM) + EPS);
#pragma unroll
          for (int bj = 0; bj < 2; ++bj) { const size_t off = (size_t)rl * DM + u.pn * 256 + bj * 128 + cl0b;
            *(f32x4*)(o + off) = acc[ai][bj][m][0] * rs * gv[bj][0]; *(f32x4*)(o + off + 4) = acc[ai][bj][m][1] * rs * gv[bj][1]; }
          if (m & 1) { asm volatile("" ::: "memory"); __builtin_amdgcn_sched_barrier(0); }
        }
    } break;
  }
}

__device__ __forceinline__ bool reg_map(int NU, int nN, int c, int i, int& pm, int& pn, int& idx_out) {
  const int xcd = c & 7, l = c >> 3, chunk = (NU + 7) >> 3, li = i * 32 + l, idx = xcd * chunk + li;
  if (li >= chunk || idx >= NU) return false;
  const int nig = 8 * nN, gid = idx / nig, r = idx % nig;
  pm = gid * 8 + (r & 7); pn = r >> 3; idx_out = idx; return true;
}
__device__ __forceinline__ bool get_unit(const Params& p, int ph, int c, int i, Unit& u) {
  char* ws = p.ws; int pm, pn, idx;
  switch (ph) {
    case 1: if (!reg_map(384 * 5, 5, c, i, pm, pn, idx)) return false;
      u.A = (const bf16_t*)(ws + OFF_XN) + (size_t)pm * 256 * 1024; u.lda = 1024; u.Bt = (const bf16_t*)(ws + OFF_WIN) + (size_t)pn * 256 * 1024; u.ldb = 1024; u.K = 1024; u.epi = E_G1; u.pm = pm; u.pn = pn;
      if (pn < 2) { const bf16_t* t = u.A; u.A = u.Bt; u.Bt = t; }
      return true;
    case 2: {
      const int xcd = c & 7, l = c >> 3;
      if (l < 17) { if (i > 0) return false;
        const int un = xcd * 17 + l, type = un / 68, r = un % 68, b = r & 3; pm = r >> 2;
        u.A = (const bf16_t*)(ws + OFF_DFTP) + (size_t)pm * 256 * (2 * KP) + type * KP; u.lda = 2 * KP; u.Bt = (const bf16_t*)(ws + OFF_UTFP) + (size_t)b * 256 * (2 * KP) + type * KP; u.ldb = 2 * KP; u.K = KP;
        u.pn = (type * 4 + b) * 4352 + pm * 256; u.pm = 0; }
      else { const int li = (l - 17) + 15 * i; if (li >= 40) return false;
        const int su = xcd * 40 + li, type = su / 160, r = su % 160, b = r / 5; pm = r % 5;
        u.A = (const bf16_t*)(ws + OFF_DFTS) + (size_t)pm * 256 * (2 * KS) + type * KS; u.lda = 2 * KS; u.Bt = (const bf16_t*)(ws + OFF_UTFS) + (size_t)b * 256 * (2 * KS) + type * KS; u.ldb = 2 * KS; u.K = KS;
        u.pn = (type * 32 + b) * 1280 + pm * 256; u.pm = 1; }
      u.epi = E_DFT; return true; }
    case 3: {
      const int NU = 384 * 11, xcd = c & 7, l = c >> 3, chunk = NU / 8, li = i * 32 + l; idx = xcd * chunk + li;
      if (li >= chunk) return false;
      const int gid = idx / 88, r = idx % 88; pm = gid * 8 + (r & 7); pn = r >> 3;
      if (pn < 5) { u.A = (const bf16_t*)(ws + OFF_CQ) + (size_t)pm * 256 * 384; u.lda = 384; u.Bt = (const bf16_t*)(ws + OFF_WQ) + (size_t)pn * 256 * 384; u.ldb = 384; u.K = 384; u.epi = E_Q; u.pn = pn; }
      else { pn -= 5; u.A = (const bf16_t*)(ws + OFF_CKV) + (size_t)pm * 256 * 256; u.lda = 256; u.Bt = (const bf16_t*)(ws + OFF_WKV) + (size_t)pn * 256 * 256; u.ldb = 256; u.K = 256; u.epi = E_KV; u.pn = pn; }
      u.pm = pm; return true; }
    case 4: if (!reg_map(384 * 4, 4, c, i, pm, pn, idx)) return false;
      u.A = (const bf16_t*)(ws + OFF_XN) + (size_t)pm * 256 * 1024; u.lda = 1024; u.Bt = (const bf16_t*)(ws + OFF_WOUT) + (size_t)pn * 256 * 1024; u.ldb = 1024; u.K = 1024; u.epi = E_OUT; u.pm = pm; u.pn = pn; return true;
    case 5: if (!reg_map(384 * 22, 22, c, i, pm, pn, idx)) return false;
      u.A = (const bf16_t*)(ws + OFF_X1B) + (size_t)pm * 256 * 1024; u.lda = 1024; u.Bt = (const bf16_t*)(ws + OFF_WGU) + (size_t)pn * 256 * 1024; u.ldb = 1024; u.K = 1024; u.epi = E_GU; u.pm = pm; u.pn = pn; return true;
    default: if (!reg_map(384 * 4, 4, c, i, pm, pn, idx)) return false;
      u.A = (const bf16_t*)(ws + OFF_H) + (size_t)pm * 256 * DFF; u.lda = DFF; u.Bt = (const bf16_t*)(ws + OFF_WD) + (size_t)pn * 256 * DFF; u.ldb = DFF; u.K = DFF; u.epi = E_DOWN; u.pm = pm; u.pn = pn; return true;
  }
}

__device__ __forceinline__ void dft_combine(const Params& p, int wid_k) {
  const int tid = opaque_tid(wid_k);
  char* ws = p.ws; bf16_t* cat = (bf16_t*)(ws + OFF_XN);
#pragma unroll
  for (int part = 0; part < 2; ++part) {
    const int S = part ? SS : SP, NB = part ? 32 : 4, RP = part ? 1280 : 4352, H = S / 2, t0 = part ? TP : 0;
    const bf16_t* pq = (const bf16_t*)(ws + (part ? OFF_PQS : OFF_PQP));
    const int nitem = NB * (H + 1) * 32;
    for (int g = blockIdx.x * 512 + tid; g < nitem; g += gridDim.x * 512) {
      const int c8 = (g & 31) * 8, r = g >> 5, b = r / (H + 1), k = r % (H + 1);
      const u32x4 pw = *(const u32x4*)(pq + ((size_t)(0 * NB + b) * RP + k) * 256 + c8);
      const u32x4 qw = *(const u32x4*)(pq + ((size_t)(1 * NB + b) * RP + k) * 256 + c8);
      u32x4 ys, yd;
#pragma unroll
      for (int e = 0; e < 4; ++e) { const float p0 = __uint_as_float(pw[e] << 16), p1 = __uint_as_float(pw[e] & 0xffff0000u), q0 = __uint_as_float(qw[e] << 16), q1 = __uint_as_float(qw[e] & 0xffff0000u);
        ys[e] = cvt_pk_bf16(p0 + q0, p1 + q1); yd[e] = cvt_pk_bf16(p0 - q0, p1 - q1); }
      *(u32x4*)(cat + (size_t)(t0 + b * S + k) * DM + c8) = ys;
      if (k > 0 && k < H) *(u32x4*)(cat + (size_t)(t0 + b * S + S - k) * DM + c8) = yd;
    }
  }
}

template <int PH>
__device__ __forceinline__ void gemm_phase(const Params& p, LAS char* lds, int wid_k) {
  const int tid = opaque_tid(wid_k), wid = __builtin_amdgcn_readfirstlane(tid >> 6), lane = tid & 63, wr = wid >> 2, wc = wid & 3, fr = lane & 15, fq = lane >> 4;
  Unit u, nx;
  bool have = get_unit(p, PH, blockIdx.x, 0, u);
  if (!have) return;
  unsigned voffA[2], voffB[2]; const char *gA0, *gA1, *gB0, *gB1;
#define G_SETUP(U) do { int t2_ = opaque_tid(wid_k); _Pragma("unroll") for (int i_ = 0; i_ < 2; ++i_) { int sR_, sC_; stage_rc(t2_ * 16 + i_ * 8192, sR_, sC_); \
      const int rho_ = sR_ & 31, sRb_ = (sR_ & ~31) + 8 * ((rho_ & 15) >> 2) + 4 * (rho_ >> 4) + (rho_ & 3); \
      voffA[i_] = (unsigned)(sR_ * (U).lda + sC_) * 2u; voffB[i_] = (unsigned)(sRb_ * (U).ldb + sC_) * 2u; } \
    gA0 = (const char*)(U).A; gA1 = gA0 + (size_t)128 * (U).lda * 2; gB0 = (const char*)(U).Bt; gB1 = gB0 + (size_t)128 * (U).ldb * 2; } while (0)
  const unsigned ldsw = (unsigned)wid * 1024u;
  const int aoff = lds_byte(wr * 64 + fr, fq * 8), boff = lds_byte(wc * 32 + fr, fq * 8);
#define G_SA(b, h) (((b) * 2 + (h)) * HTB)
#define G_SB(b, h) ((4 + (b) * 2 + (h)) * HTB)
#define G_STAGE(bufoff, gbase, voff, kt) do { _Pragma("unroll") for (int _i = 0; _i < 2; ++_i) \
    __builtin_amdgcn_global_load_lds((const unsigned*)((gbase) + (size_t)(kt) * (BK * 2) + (voff)[_i]), (LAS unsigned*)(lds + (bufoff) + ldsw + _i * 8192), 16, 0, 0); } while (0)
#define G_LDA(dst, b, h) do { _Pragma("unroll") for (int m = 0; m < 4; ++m) _Pragma("unroll") for (int k = 0; k < 2; ++k) dst[m][k] = *(const LAS bf16x8*)(lds + G_SA(b, h) + aoff + m * 2048 + k * 1024); } while (0)
#define G_LDB(dst, b, h) do { _Pragma("unroll") for (int n = 0; n < 2; ++n) _Pragma("unroll") for (int k = 0; k < 2; ++k) dst[n][k] = *(const LAS bf16x8*)(lds + G_SB(b, h) + boff + n * 2048 + k * 1024); } while (0)
#define G_MMA(ai, bj, At, Bt) do { __builtin_amdgcn_s_setprio(1); _Pragma("unroll") for (int m = 0; m < 4; ++m) _Pragma("unroll") for (int n = 0; n < 2; ++n) _Pragma("unroll") for (int k = 0; k < 2; ++k) \
    acc[ai][bj][m][n] = __builtin_amdgcn_mfma_f32_16x16x32_bf16(Bt[n][k], At[m][k], acc[ai][bj][m][n], 0, 0, 0); __builtin_amdgcn_s_setprio(0); } while (0)
#define WAIT_V(n) asm volatile("s_waitcnt vmcnt(" #n ")" ::: "memory")
#define WAIT_L(n) asm volatile("s_waitcnt lgkmcnt(" #n ")" ::: "memory")
#define BAR __builtin_amdgcn_s_barrier()
#define SCHED __builtin_amdgcn_sched_barrier(0)
#define G_PROLOGUE() do { G_STAGE(G_SB(0, 0), gB0, voffB, 0); G_STAGE(G_SA(0, 0), gA0, voffA, 0); G_STAGE(G_SB(0, 1), gB1, voffB, 0); G_STAGE(G_SA(0, 1), gA1, voffA, 0); \
    G_STAGE(G_SB(1, 0), gB0, voffB, 1); G_STAGE(G_SA(1, 0), gA0, voffA, 1); G_STAGE(G_SB(1, 1), gB1, voffB, 1); } while (0)
  G_SETUP(u);
  asm volatile("s_waitcnt vmcnt(0) lgkmcnt(0)" ::: "memory");
  __syncthreads();
  G_PROLOGUE();
  constexpr int RR_OFF = 8 * HTB + 4096;
  int rbuf = 0;
  if (PH == 5) { const int t0_ = opaque_tid(wid_k);
    if (t0_ < 256) { const f32x4 q = *(const f32x4*)((const float*)(p.ws + OFF_SSQ1) + (size_t)(u.pm * 256 + t0_) * 4);
      ((LAS float*)(lds + RR_OFF))[t0_] = __builtin_amdgcn_rsqf(((q[0] + q[1]) + (q[2] + q[3])) * (1.0f / DM) + EPS); } }
  for (int ui = 0; have; ++ui) {
    const int nt = u.K / BK;
    G_SETUP(u);
    Acc acc;
#pragma unroll
    for (int a = 0; a < 2; ++a)
#pragma unroll
      for (int b = 0; b < 2; ++b)
#pragma unroll
        for (int m = 0; m < 4; ++m)
#pragma unroll
          for (int n = 0; n < 2; ++n) acc[a][b][m][n] = (f32x4){0.f, 0.f, 0.f, 0.f};
    bf16x8 At[4][2], B0[2][2], B1[2][2];
    asm volatile("s_waitcnt vmcnt(0) lgkmcnt(0)" ::: "memory");
    __syncthreads();
    if (wr == 1) BAR;
  for (int t = 0; t < nt - 2; t += 2) {
      G_LDB(B0, 0, 0); SCHED; G_LDA(At, 0, 0); G_STAGE(G_SA(1, 1), gA1, voffA, t + 1);
      WAIT_L(8); BAR; WAIT_L(0); G_MMA(0, 0, At, B0); BAR; SCHED;
      G_LDB(B1, 0, 1); G_STAGE(G_SB(0, 0), gB0, voffB, t + 2);
      BAR; WAIT_L(0); G_MMA(0, 1, At, B1); BAR;
      G_LDA(At, 0, 1); G_STAGE(G_SA(0, 0), gA0, voffA, t + 2);
      BAR; WAIT_L(0); G_MMA(1, 0, At, B0); BAR; SCHED;
      G_STAGE(G_SB(0, 1), gB1, voffB, t + 2);
      WAIT_V(6); BAR; G_MMA(1, 1, At, B1); BAR;
      G_LDB(B0, 1, 0); SCHED; G_LDA(At, 1, 0); G_STAGE(G_SA(0, 1), gA1, voffA, t + 2);
      WAIT_L(8); BAR; WAIT_L(0); G_MMA(0, 0, At, B0); BAR; SCHED;
      G_LDB(B1, 1, 1); G_STAGE(G_SB(1, 0), gB0, voffB, t + 3);
      BAR; WAIT_L(0); G_MMA(0, 1, At, B1); BAR;
      G_LDA(At, 1, 1); G_STAGE(G_SA(1, 0), gA0, voffA, t + 3);
      BAR; WAIT_L(0); G_MMA(1, 0, At, B0); BAR; SCHED;
      G_STAGE(G_SB(1, 1), gB1, voffB, t + 3);
      WAIT_V(6); BAR; G_MMA(1, 1, At, B1); BAR;
    }
    { G_LDB(B0, 0, 0); G_LDA(At, 0, 0); G_STAGE(G_SA(1, 1), gA1, voffA, nt - 1);
      BAR; WAIT_L(0); G_MMA(0, 0, At, B0); BAR;
      G_LDB(B1, 0, 1); BAR; WAIT_L(0); G_MMA(0, 1, At, B1); BAR;
      G_LDA(At, 0, 1); WAIT_V(4); BAR; WAIT_L(0); G_MMA(1, 0, At, B0); G_MMA(1, 1, At, B1); BAR; }
    { G_LDB(B0, 1, 0); G_LDA(At, 1, 0); WAIT_V(2); BAR; WAIT_L(0); G_MMA(0, 0, At, B0); BAR;
      G_LDB(B1, 1, 1); WAIT_V(0); BAR; WAIT_L(0); G_MMA(0, 1, At, B1); BAR;
      G_LDA(At, 1, 1); BAR; WAIT_L(0); G_MMA(1, 0, At, B0); G_MMA(1, 1, At, B1); BAR; }
    if (wr == 0) BAR;
    asm volatile("" ::: "memory"); SCHED;
    const bool hn = get_unit(p, PH, blockIdx.x, ui + 1, nx);
    if (hn) { G_SETUP(nx); G_PROLOGUE(); }
    f32x4 nq = {0.f, 0.f, 0.f, 0.f};
    if (PH == 5 && hn) { const int t1_ = opaque_tid(wid_k); if (t1_ < 256) nq = *(const f32x4*)((const float*)(p.ws + OFF_SSQ1) + (size_t)(nx.pm * 256 + t1_) * 4); }
    u.aux = RR_OFF + rbuf * 1024;
    asm volatile("" ::: "memory"); SCHED;
    { int te = opaque_tid(wid_k);
      const int ewid = te >> 6, elane = te & 63, ewr = ewid >> 2, ewc = ewid & 3, efr = elane & 15, efq = elane >> 4;
      if (PH == 1) epilogue<E_G1>(p, u, acc, lds, te, ewr, ewc, efr, efq);
      else if (PH == 2) epilogue<E_DFT>(p, u, acc, lds, te, ewr, ewc, efr, efq);
      else if (PH == 3) { if (u.epi == E_Q) epilogue<E_Q>(p, u, acc, lds, te, ewr, ewc, efr, efq); else epilogue<E_KV>(p, u, acc, lds, te, ewr, ewc, efr, efq); }
      else if (PH == 4) epilogue<E_OUT>(p, u, acc, lds, te, ewr, ewc, efr, efq);
      else if (PH == 5) epilogue<E_GU>(p, u, acc, lds, te, ewr, ewc, efr, efq);
      else epilogue<E_DOWN>(p, u, acc, lds, te, ewr, ewc, efr, efq);
      if (PH == 5 && hn && te < 256) ((LAS float*)(lds + RR_OFF + (rbuf ^ 1) * 1024))[te] = __builtin_amdgcn_rsqf(((nq[0] + nq[1]) + (nq[2] + nq[3])) * (1.0f / DM) + EPS); }
    rbuf ^= 1;
    u = nx; have = hn;
  }
  asm volatile("s_waitcnt vmcnt(0) lgkmcnt(0)" ::: "memory");
  __syncthreads();
}

constexpr int SHM_V = 64 * 128 * 2, SHM_K = 64 * 192 * 2;
#define KSWZ(row, colB) ((row) * 384 + ((colB) ^ ((((row) >> 1) & 7) << 4)))
#define SBAR() __builtin_amdgcn_sched_barrier(0)
constexpr float THR = 8.0f;
__device__ __forceinline__ int crow(int r, int hi) { return (r & 3) + 8 * (r >> 2) + 4 * hi; }
__device__ __forceinline__ void partialSM(f32x16& p0, f32x16& p1, float& m_reg, float& mn, float& alpha) {
  float pmax = p0[0];
#pragma unroll
  for (int r = 1; r < 16; ++r) pmax = fmaxf(pmax, p0[r]);
#pragma unroll
  for (int r = 0; r < 16; ++r) pmax = fmaxf(pmax, p1[r]);
  { auto rr = __builtin_amdgcn_permlane32_swap(__float_as_uint(pmax), __float_as_uint(pmax), false, false); pmax = fmaxf(__uint_as_float(rr[0]), __uint_as_float(rr[1])); }
  if (__builtin_expect(__all(pmax - m_reg <= THR), 1)) { mn = m_reg; alpha = 1.f; }
  else { mn = fmaxf(m_reg, pmax); alpha = __builtin_amdgcn_exp2f(m_reg - mn); m_reg = mn; }
#pragma unroll
  for (int r = 0; r < 16; ++r) p0[r] = p0[r] - mn;
#pragma unroll
  for (int r = 0; r < 16; ++r) p1[r] = p1[r] - mn;
#pragma unroll
  for (int r = 0; r < 16; ++r) p0[r] = __builtin_amdgcn_exp2f(p0[r]);
}
__device__ __forceinline__ void finishSM(f32x16& p0, f32x16& p1, float alpha, float& l_reg, bf16x8& pa0, bf16x8& pa1, bf16x8& pa2, bf16x8& pa3) {
#pragma unroll
  for (int r = 0; r < 16; ++r) p1[r] = __builtin_amdgcn_exp2f(p1[r]);
  float ps = 0;
#pragma unroll
  for (int r = 0; r < 16; ++r) ps += p0[r];
#pragma unroll
  for (int r = 0; r < 16; ++r) ps += p1[r];
  { auto rr = __builtin_amdgcn_permlane32_swap(__float_as_uint(ps), __float_as_uint(ps), false, false); ps = __uint_as_float(rr[0]) + __uint_as_float(rr[1]); }
  l_reg = l_reg * alpha + ps;
#define PK4(P, BASE, OUT) do { unsigned a0 = cvt_pk_bf16(P[BASE + 0], P[BASE + 1]), a1 = cvt_pk_bf16(P[BASE + 2], P[BASE + 3]);   \
    unsigned b0 = cvt_pk_bf16(P[BASE + 4], P[BASE + 5]), b1 = cvt_pk_bf16(P[BASE + 6], P[BASE + 7]);                              \
    auto r0 = __builtin_amdgcn_permlane32_swap(a0, b0, false, false); auto r1 = __builtin_amdgcn_permlane32_swap(a1, b1, false, false); \
    u32x4 w = {r0[0], r1[0], r0[1], r1[1]}; OUT = *reinterpret_cast<bf16x8*>(&w); } while (0)
  PK4(p0, 0, pa0); PK4(p0, 8, pa1); PK4(p1, 0, pa2); PK4(p1, 8, pa3);
#undef PK4
}
__device__ __forceinline__ int v_st(int k, int c) { const int kk = (k & ~0xC) | ((k & 4) << 1) | ((k & 8) >> 1); return ((kk >> 3) * 4 + (c >> 5)) * 512 + ((kk & 7) * 32 + (c & 31)) * 2; }
__device__ __forceinline__ int v_rd_base(int lane) { return ((lane & 3) << 3) | (((lane >> 2) & 3) << 6) | (((lane >> 4) & 1) << 5) | (((lane >> 5) & 1) << 8); }
constexpr int v_rd_off(int d0, int ks, int half) { return d0 * 512 + ks * 4096 + half * 2048; }
struct VF { s16x4 l0, h0, l1, h1, l2, h2, l3, h3; };
#define TRR(off) __builtin_amdgcn_ds_read_tr16_b64_v4i16((LAS s16x4*)(vb + (off)))
template <int D0> __device__ __forceinline__ void load_vf(VF& f, LAS char* vb) {
  f.l0 = TRR(v_rd_off(D0, 0, 0)); f.h0 = TRR(v_rd_off(D0, 0, 1)); f.l1 = TRR(v_rd_off(D0, 1, 0)); f.h1 = TRR(v_rd_off(D0, 1, 1));
  f.l2 = TRR(v_rd_off(D0, 2, 0)); f.h2 = TRR(v_rd_off(D0, 2, 1)); f.l3 = TRR(v_rd_off(D0, 3, 0)); f.h3 = TRR(v_rd_off(D0, 3, 1));
}
#undef TRR
__device__ __forceinline__ void mma_vf(f32x16& od, const VF& f, bf16x8 pa0, bf16x8 pa1, bf16x8 pa2, bf16x8 pa3) {
#define PK(L, H) (bf16x8){L[0], L[1], L[2], L[3], H[0], H[1], H[2], H[3]}
  od = __builtin_amdgcn_mfma_f32_32x32x16_bf16(pa0, PK(f.l0, f.h0), od, 0, 0, 0);
  od = __builtin_amdgcn_mfma_f32_32x32x16_bf16(pa1, PK(f.l1, f.h1), od, 0, 0, 0);
  od = __builtin_amdgcn_mfma_f32_32x32x16_bf16(pa2, PK(f.l2, f.h2), od, 0, 0, 0);
  od = __builtin_amdgcn_mfma_f32_32x32x16_bf16(pa3, PK(f.l3, f.h3), od, 0, 0, 0);
#undef PK
}

__device__ __forceinline__ void attn_unit(const bf16_t* __restrict__ Qb, const bf16_t* __restrict__ Knb, const bf16_t* __restrict__ Krb, const bf16_t* __restrict__ Vb,
                                          bf16_t* __restrict__ Ob, int seq, LAS char* lds, int wid_k) {
  const int tid = opaque_tid(wid_k), wid = __builtin_amdgcn_readfirstlane(tid >> 6), lane = tid & 63, r32 = lane & 31, hi = lane >> 5, grp = wid >> 2;
  LAS char* V_lds = lds; LAS char* K_lds = lds + 3 * SHM_V;
  LAS float* wsl = (LAS float*)(lds + 3 * SHM_V + 2 * SHM_K) + wid * 64; LAS float* li_l = wsl; LAS float* al_l = wsl + 32;
  float m_reg = -1e30f, l_reg = 0; f32x16 o[4] = {}; bf16x8 qr[8];
  const bf16_t* Qw = Qb + (size_t)(wid * 32 + r32) * 1152 + hi * 8;
#pragma unroll
  for (int d0 = 0; d0 < 8; ++d0) qr[d0] = *(const bf16x8*)(Qw + d0 * 16);
  LAS char* qrl = lds + 3 * SHM_V + 2 * SHM_K + 2048 + wid * 4096 + r32 * 128; const int qsw = (r32 >> 1) & 7;
  const int sr = tid >> 4, sc = (tid & 15) * 8, vst0 = v_st(sr, sc);
  const int kst0 = KSWZ(sr, sc * 2), rr = tid >> 3, rc = (tid & 7) * 8, kst2 = KSWZ(rr, 256 + rc * 2);
  const unsigned goff0 = sr * 768 + sc, goff2 = rr * 64 + rc;
  const int vrb_abs = (int)(uintptr_t)V_lds + v_rd_base(lane);
  int kx[4], qx[4];
#pragma unroll
  for (int q = 0; q < 4; ++q) { kx[q] = (int)(uintptr_t)K_lds + r32 * 384 + ((q * 32 + hi * 16) ^ (((r32 >> 1) & 7) << 4)); qx[q] = (int)(uintptr_t)qrl + (((q * 2 + hi) ^ qsw) << 4); }
  int vpv = 0, vw = (1 + grp) * SHM_V;
#define LP(x) ((LAS char*)(size_t)(unsigned)(x))
  bf16x8 vs0, vs1, ks0, ks1, ks2;
#define SLOAD(t) do { const size_t k0_ = (size_t)(t) * 64; const bf16_t* vp = Vb + k0_ * 768; const bf16_t* kp = Knb + k0_ * 768; const bf16_t* rp = Krb + k0_ * 64; \
    vs0 = *(const bf16x8*)(vp + goff0); vs1 = *(const bf16x8*)(vp + goff0 + 32 * 768); ks0 = *(const bf16x8*)(kp + goff0); ks1 = *(const bf16x8*)(kp + goff0 + 32 * 768); ks2 = *(const bf16x8*)(rp + goff2); } while (0)
#define SWRITE(t, voff) do { LAS char* vd = V_lds + (voff); LAS char* kd = K_lds + ((t) & 1) * SHM_K; \
    *(LAS bf16x8*)(vd + vst0) = vs0; *(LAS bf16x8*)(vd + vst0 + 8192) = vs1; \
    *(LAS bf16x8*)(kd + kst0) = ks0; *(LAS bf16x8*)(kd + kst0 + 12288) = ks1; *(LAS bf16x8*)(kd + kst2) = ks2; } while (0)
#define SWAIT() asm volatile("s_waitcnt vmcnt(0)" ::: "memory")
#define LBAR() do { asm volatile("s_waitcnt lgkmcnt(0)" ::: "memory"); SBAR(); __builtin_amdgcn_s_barrier(); SBAR(); } while (0)
#define RESC(a) do { if (__any((a) < 1.f)) { if (hi == 0) al_l[r32] = (a); asm volatile("s_waitcnt lgkmcnt(0)" ::: "memory"); \
    _Pragma("unroll") for (int d = 0; d < 4; ++d) _Pragma("unroll") for (int r = 0; r < 16; ++r) o[d][r] *= al_l[crow(r, hi)]; } } while (0)
  f32x16 p0, p1; float mn, al; bf16x8 pa0, pa1, pa2, pa3; const int NT = seq / 64, ahead = 1 + grp;
  __syncthreads();
  { bf16x8 t0 = *(const bf16x8*)(Qw + 128), t1 = *(const bf16x8*)(Qw + 144), t2 = *(const bf16x8*)(Qw + 160), t3 = *(const bf16x8*)(Qw + 176);
    *(LAS bf16x8*)(qrl + (((0 + hi) ^ qsw) << 4)) = t0; *(LAS bf16x8*)(qrl + (((2 + hi) ^ qsw) << 4)) = t1;
    *(LAS bf16x8*)(qrl + (((4 + hi) ^ qsw) << 4)) = t2; *(LAS bf16x8*)(qrl + (((6 + hi) ^ qsw) << 4)) = t3; }
  SLOAD(0); SWAIT(); SWRITE(0, 0);
  SLOAD(1);
  LBAR();
  if (grp == 1) { SWAIT(); SWRITE(1, SHM_V); SLOAD(2); LBAR(); }
  for (int j = 0; j < NT; ++j) {
    __builtin_amdgcn_s_setprio(1);
    {
      const int kbo = (j & 1) * SHM_K;
      int ka0 = kx[0] + kbo, ka1 = kx[1] + kbo, ka2 = kx[2] + kbo, ka3 = kx[3] + kbo;
      asm volatile("" : "+v"(ka0), "+v"(ka1), "+v"(ka2), "+v"(ka3));
      bf16x8 kb0[3], kb1[3], qf[3];
#define KA(q) ((q) == 0 ? ka0 : (q) == 1 ? ka1 : (q) == 2 ? ka2 : ka3)
#define KLOAD(d0) do { LAS const char* kp_ = LP(KA((d0) & 3)) + ((d0) >> 2) * 128; kb0[(d0) % 3] = *(LAS const bf16x8*)kp_; kb1[(d0) % 3] = *(LAS const bf16x8*)(kp_ + 32 * 384); \
        if ((d0) >= 8) qf[(d0) % 3] = *(LAS const bf16x8*)LP(qx[(d0) - 8]); } while (0)
      if (j > 0) {
        int va_ = vrb_abs + vpv; asm volatile("" : "+v"(va_)); LAS char* vb = LP(va_);
        vpv = (vpv == 2 * SHM_V) ? 0 : vpv + SHM_V;
        VF va, vbf;
        load_vf<0>(va, vb); load_vf<1>(vbf, vb); SBAR();
        mma_vf(o[0], va, pa0, pa1, pa2, pa3); load_vf<2>(va, vb); SBAR();
        mma_vf(o[1], vbf, pa0, pa1, pa2, pa3); load_vf<3>(vbf, vb); SBAR();
        KLOAD(0); KLOAD(1);
        mma_vf(o[2], va, pa0, pa1, pa2, pa3); SBAR();
        mma_vf(o[3], vbf, pa0, pa1, pa2, pa3); SBAR();
      } else { KLOAD(0); KLOAD(1); SBAR(); }
      const f32x16 zero16 = {};
#pragma unroll
      for (int d0 = 0; d0 < 12; ++d0) {
        if (d0 + 2 < 12) KLOAD(d0 + 2);
        const bf16x8 qv = d0 < 8 ? qr[d0 & 7] : qf[d0 % 3];
        p0 = __builtin_amdgcn_mfma_f32_32x32x16_bf16(kb0[d0 % 3], qv, d0 == 0 ? zero16 : p0, 0, 0, 0);
        p1 = __builtin_amdgcn_mfma_f32_32x32x16_bf16(kb1[d0 % 3], qv, d0 == 0 ? zero16 : p1, 0, 0, 0);
        SBAR();
      }
#undef KLOAD
#undef KA
    }
    __builtin_amdgcn_s_setprio(0);
    LBAR();
    partialSM(p0, p1, m_reg, mn, al);
    RESC(al);
    finishSM(p0, p1, al, l_reg, pa0, pa1, pa2, pa3);
    { const int tw = j + ahead; if (tw < NT) { SWAIT(); SWRITE(tw, vw); if (tw + 1 < NT) SLOAD(tw + 1); } vw = (vw == 2 * SHM_V) ? 0 : vw + SHM_V; }
    LBAR();
  }
  { int va_ = vrb_abs + vpv; asm volatile("" : "+v"(va_)); LAS char* vb = LP(va_); VF va, vbf;
    load_vf<0>(va, vb); load_vf<1>(vbf, vb); SBAR();
    mma_vf(o[0], va, pa0, pa1, pa2, pa3); load_vf<2>(va, vb); SBAR();
    mma_vf(o[1], vbf, pa0, pa1, pa2, pa3); load_vf<3>(vbf, vb); SBAR();
    mma_vf(o[2], va, pa0, pa1, pa2, pa3); mma_vf(o[3], vbf, pa0, pa1, pa2, pa3); }
  if (grp == 0) LBAR();
  if (hi == 0) li_l[r32] = l_reg; asm volatile("s_waitcnt lgkmcnt(0)" ::: "memory");
  bf16_t* Ow = Ob + (size_t)(wid * 32) * 1024;
  float rli[16];
#pragma unroll
  for (int r = 0; r < 16; ++r) rli[r] = __builtin_amdgcn_rcpf(li_l[crow(r, hi)]);
  LAS char* ot = lds + 3 * SHM_V + 2 * SHM_K + 2048 + wid * 4096;
#pragma unroll
  for (int d0 = 0; d0 < 4; ++d0) {
#pragma unroll
    for (int r = 0; r < 16; ++r) *(LAS bf16_t*)(ot + crow(r, hi) * 80 + r32 * 2) = f2bf(o[d0][r] * rli[r]);
    asm volatile("s_waitcnt lgkmcnt(0)" ::: "memory");
    u32x4 v0 = *(LAS u32x4*)(ot + (lane >> 2) * 80 + (lane & 3) * 16), v1 = *(LAS u32x4*)(ot + (16 + (lane >> 2)) * 80 + (lane & 3) * 16);
    asm volatile("s_waitcnt lgkmcnt(0)" ::: "memory");
    *(u32x4*)(Ow + (size_t)(lane >> 2) * 1024 + d0 * 32 + (lane & 3) * 8) = v0;
    *(u32x4*)(Ow + (size_t)(16 + (lane >> 2)) * 1024 + d0 * 32 + (lane & 3) * 8) = v1;
  }
#undef SLOAD
#undef SWRITE
#undef SWAIT
#undef RESC
#undef LBAR
#undef LP
}

__device__ __forceinline__ void attn_phase(const Params& p, LAS char* lds, int wid_k) {
  char* ws = p.ws; const int c = blockIdx.x, xcd = c & 7, l = c >> 3;
  const bf16_t* Q = (const bf16_t*)(ws + OFF_Q); const bf16_t* Kn = (const bf16_t*)(ws + OFF_KN); const bf16_t* Kr = (const bf16_t*)(ws + OFF_KR); const bf16_t* V = (const bf16_t*)(ws + OFF_V);
  bf16_t* cat = (bf16_t*)(ws + OFF_XN);
  for (int i = 0; i < 9; ++i) {
    int b, h, t0, seq, tq;
    if (i < 3) { const int bh = i * 8 + xcd; b = bh / 6; h = bh % 6; seq = SP; t0 = b * SP; tq = t0 + l * 256; }
    else { const int bh = ((i - 3) * 8 + xcd) * 4 + (l >> 3); b = bh / 6; h = bh % 6; seq = SS; t0 = TP + b * SS; tq = t0 + (l & 7) * 256; }
    attn_unit(Q + (size_t)tq * 1152 + h * 192, Kn + (size_t)t0 * 768 + h * 128, Kr + (size_t)t0 * 64, V + (size_t)t0 * 768 + h * 128, cat + (size_t)tq * 1024 + 256 + h * 128, seq, lds, wid_k);
  }
}

constexpr int SHM_BYTES = 136 * 1024;

__global__ void __launch_bounds__(512) fwd_megakernel(Params p) {
  extern __shared__ __attribute__((aligned(16))) char shm_[];
  LAS char* lds = (LAS char*)shm_;
  cg::grid_group grid = cg::this_grid();
  const int wid_k = __builtin_amdgcn_readfirstlane((int)threadIdx.x >> 6);
  volatile LAS unsigned* xst = (volatile LAS unsigned*)(lds + SHM_BYTES - 16);
  if (opaque_tid(wid_k) == 0) { xst[0] = 0u; xst[1] = 0u; }
  __syncthreads();
  XcdBarrier xb = xcd_barrier_post((unsigned*)(p.ws + OFF_BAR), xst, wid_k);
  phaseA(p, lds, wid_k);
  if (p.ws == nullptr) grid.sync();
  xcd_barrier(xb, wid_k);
#ifndef NO_P1
  gemm_phase<1>(p, lds, wid_k);
  { const int l_ = blockIdx.x >> 3; if (l_ >= 16) dft_gen(p, (blockIdx.x & 7) * 16 + (l_ - 16), 128, wid_k); }
#endif
  xcd_barrier(xb, wid_k);
#ifndef NO_P2
  dft_fold(p, wid_k);
  xcd_barrier(xb, wid_k);
  gemm_phase<2>(p, lds, wid_k);
  { const int l_ = blockIdx.x >> 3; if (l_ >= 17) wprep(p, lds, 3, 6, (blockIdx.x & 7) * 15 + (l_ - 17), 120, wid_k); }
#endif
  xcd_barrier(xb, wid_k);
#ifndef NO_P3
  dft_combine(p, wid_k);
  gemm_phase<3>(p, lds, wid_k);
#endif
  xcd_barrier(xb, wid_k);
#ifndef NO_ATTN
  attn_phase(p, lds, wid_k);
#endif
  xcd_barrier(xb, wid_k);
#ifndef NO_P4
  gemm_phase<4>(p, lds, wid_k);
#endif
  xcd_barrier(xb, wid_k);
#ifndef NO_P5
  gemm_phase<5>(p, lds, wid_k);
#endif
  xcd_barrier(xb, wid_k);
#ifndef NO_P6
  gemm_phase<6>(p, lds, wid_k);
#endif
}

extern "C" void kernel_launch(void* const* d_in, const int* in_sizes, int n_in, void* d_out, int out_size, void* d_ws, size_t ws_size, hipStream_t stream) {
  if (n_in != 14 || ws_size < WS_NEED || out_size != T * DM) { fprintf(stderr, "kernel_launch: unexpected shapes (n_in %d, ws %zu, out %d)\n", n_in, ws_size, out_size); return; }
  static int grid_blocks = 0;
  if (!grid_blocks) {
    hipFuncSetAttribute((const void*)fwd_megakernel, hipFuncAttributeMaxDynamicSharedMemorySize, SHM_BYTES);
    int dev = 0, cus = 0, per_cu = 0;
    hipGetDevice(&dev);
    hipDeviceGetAttribute(&cus, hipDeviceAttributeMultiprocessorCount, dev);
    hipOccupancyMaxActiveBlocksPerMultiprocessor(&per_cu, fwd_megakernel, 512, SHM_BYTES);
    if (per_cu < 1) { fprintf(stderr, "kernel_launch: occupancy 0\n"); return; }
    grid_blocks = cus < 256 ? cus : 256;
    if (grid_blocks != 256) fprintf(stderr, "kernel_launch: warning: %d CUs\n", cus);
  }
  Params p{};
  p.x_prompt = (const float*)d_in[0]; p.x_sample = (const float*)d_in[1]; p.norm_mix_g = (const float*)d_in[2]; p.w_in = (const float*)d_in[3];
  p.q_norm_g = (const float*)d_in[4]; p.w_q_up = (const float*)d_in[5]; p.kv_norm_g = (const float*)d_in[6]; p.w_kv_up = (const float*)d_in[7];
  p.w_out = (const float*)d_in[8]; p.norm_ffn_g = (const float*)d_in[9]; p.w_gate = (const float*)d_in[10]; p.w_up = (const float*)d_in[11];
  p.w_down = (const float*)d_in[12]; p.final_g = (const float*)d_in[13];
  p.out = (float*)d_out; p.ws = (char*)d_ws;
  (void)hipMemsetAsync((char*)d_ws + OFF_BAR, 0, 16384 + 384 * 64, stream);
  void* args[] = {&p};
  hipError_t e = hipLaunchCooperativeKernel((void*)fwd_megakernel, dim3(grid_blocks), dim3(512), args, SHM_BYTES, stream);
  if (e != hipSuccess) fprintf(stderr, "cooperative launch failed: %s (grid %d)\n", hipGetErrorString(e), grid_blocks);
}
```
